# Optimizing an MI355X kernel written in HIP

```python
import math
import jax, jax.numpy as jnp
from jax import lax
import numpy as np

D_MODEL = 1024
BATCH = 8
SEQ = 8192
DEPTH = 1

GRID_W = 64
N_Q_HEADS = 8
N_KV_HEADS = 2
HEAD_DIM = 128
Q_BLOCK = 128
ROPE_THETA = 10000.0
ROPE_AXIS_DIM = HEAD_DIM // 2
N_FOURIER_GROUPS = 4
FOURIER_GROUP_DIM = 128
FOURIER_DIM = N_FOURIER_GROUPS * FOURIER_GROUP_DIM
N_BRANCHES = 2
Q_DIM = N_Q_HEADS * HEAD_DIM
KV_DIM = N_KV_HEADS * HEAD_DIM
IN_COLS = FOURIER_DIM + Q_DIM + 2 * KV_DIM + N_BRANCHES * D_MODEL
N_EXPERTS = 32
TOP_K = 4
D_EXPERT = 1024
SWIGLU_LIMIT = 7.0
SWIGLU_ALPHA = 1.702
MOE_BLOCK = 128
N_MOD = 6
DEEPNORM_ALPHA = (2 * DEPTH) ** 0.25
DEEPNORM_BETA = (8 * DEPTH) ** -0.25
LN_EPS = 1e-5
ADA_EPS = 1e-6
QK_EPS = 1e-6

kernel_name = "hybrid_fourier_gqa_moe_deepnorm_block"


def layer_norm(x, g=None, b=None, eps=LN_EPS):
    xf = x.astype(jnp.float32)
    mu = jnp.mean(xf, axis=-1, keepdims=True)
    var = jnp.mean(jnp.square(xf - mu), axis=-1, keepdims=True)
    y = (xf - mu) * lax.rsqrt(var + eps)
    if g is not None:
        y = y * g.astype(jnp.float32) + b.astype(jnp.float32)
    return y.astype(x.dtype)


def rms_norm(x, g, eps=QK_EPS):
    xf = x.astype(jnp.float32)
    y = xf * lax.rsqrt(jnp.mean(jnp.square(xf), axis=-1, keepdims=True) + eps)
    return (y * g.astype(jnp.float32)).astype(x.dtype)


def axial_rope_angles(seq):
    rows = seq // GRID_W
    row_ids = jnp.repeat(jnp.arange(rows, dtype=jnp.float32), GRID_W)
    col_ids = jnp.tile(jnp.arange(GRID_W, dtype=jnp.float32), rows)
    freqs = ROPE_THETA ** (-jnp.arange(0, ROPE_AXIS_DIM, 2, dtype=jnp.float32) / ROPE_AXIS_DIM)
    return row_ids[:, None] * freqs, col_ids[:, None] * freqs


def _rotate_half(x, ang):
    cos = jnp.cos(ang)[:, None, :].astype(x.dtype)
    sin = jnp.sin(ang)[:, None, :].astype(x.dtype)
    x1, x2 = jnp.split(x, 2, axis=-1)
    return jnp.concatenate([x1 * cos - x2 * sin, x2 * cos + x1 * sin], axis=-1)


def apply_axial_rope(x, ang_r, ang_c):
    return jnp.concatenate([_rotate_half(x[..., :ROPE_AXIS_DIM], ang_r),
                            _rotate_half(x[..., ROPE_AXIS_DIM:], ang_c)], axis=-1)


def fourier_mix(f):
    b, s, _ = f.shape
    g = f.astype(jnp.float32).reshape(b, s, N_FOURIER_GROUPS, FOURIER_GROUP_DIM)
    y = jnp.fft.fftn(g, axes=(1, 3), norm="ortho").real
    return y.reshape(b, s, FOURIER_DIM).astype(f.dtype)


def blocked_gqa(q, k, v):
    b, s, _, _ = q.shape
    grp = N_Q_HEADS // N_KV_HEADS
    nblk = s // Q_BLOCK
    scale = 1.0 / math.sqrt(HEAD_DIM)
    qb = q.reshape(b, nblk, Q_BLOCK, N_KV_HEADS, grp, HEAD_DIM).transpose(1, 0, 2, 3, 4, 5)

    def one_block(q_blk):
        sc = jnp.einsum('bqhgd,bkhd->bhgqk', q_blk, k, preferred_element_type=jnp.float32) * scale
        p = jax.nn.softmax(sc, axis=-1).astype(v.dtype)
        return jnp.einsum('bhgqk,bkhd->bqhgd', p, v)

    o = lax.map(one_block, qb)
    return o.transpose(1, 0, 2, 3, 4, 5).reshape(b, s, Q_DIM)


def mixing_sublayer(u, w_in, q_norm_g, k_norm_g, w_fourier, w_attn_o, w_out, ang_r, ang_c):
    b, s, _ = u.shape
    z = u @ w_in
    cuts = np.cumsum([FOURIER_DIM, Q_DIM, KV_DIM, KV_DIM]).tolist()
    f, q, k, v, gates = jnp.split(z, cuts, axis=-1)
    y_f = fourier_mix(f) @ w_fourier
    q = apply_axial_rope(rms_norm(q.reshape(b, s, N_Q_HEADS, HEAD_DIM), q_norm_g), ang_r, ang_c)
    k = apply_axial_rope(rms_norm(k.reshape(b, s, N_KV_HEADS, HEAD_DIM), k_norm_g), ang_r, ang_c)
    v = v.reshape(b, s, N_KV_HEADS, HEAD_DIM)
    y_a = blocked_gqa(q, k, v) @ w_attn_o
    g_f, g_a = jnp.split(gates, N_BRANCHES, axis=-1)
    m = jax.nn.sigmoid(g_f) * y_f + jax.nn.sigmoid(g_a) * y_a
    return m @ w_out


def moe_sublayer(u, w_router, b_router, w_gate_up, b_gate_up, w_down, b_down):
    b, s, d = u.shape
    n = b * s
    xf = u.reshape(n, d)
    logits = (xf @ w_router + b_router).astype(jnp.float32)
    top_vals, top_idx = lax.top_k(logits, TOP_K)
    top_w = jax.nn.softmax(top_vals, axis=-1)

    n_slots = n * TOP_K
    e_flat = top_idx.reshape(n_slots).astype(jnp.int32)
    w_flat = top_w.reshape(n_slots)
    tok_flat = jnp.arange(n_slots, dtype=jnp.int32) // TOP_K

    order = jnp.argsort(e_flat)
    sorted_e = e_flat[order]
    counts = jnp.zeros((N_EXPERTS,), jnp.int32).at[e_flat].add(1)
    starts = jnp.cumsum(counts) - counts
    pcounts = ((counts + MOE_BLOCK - 1) // MOE_BLOCK) * MOE_BLOCK
    pends = jnp.cumsum(pcounts)
    pstarts = pends - pcounts
    dest = pstarts[sorted_e] + (jnp.arange(n_slots, dtype=jnp.int32) - starts[sorted_e])

    n_pad = n_slots + N_EXPERTS * MOE_BLOCK
    nblk = n_pad // MOE_BLOCK
    buf_tok = jnp.zeros((n_pad,), jnp.int32).at[dest].set(tok_flat[order])
    buf_w = jnp.zeros((n_pad,), jnp.float32).at[dest].set(w_flat[order])
    buf_valid = jnp.zeros((n_pad,), jnp.bool_).at[dest].set(True)
    block_starts = jnp.arange(nblk, dtype=jnp.int32) * MOE_BLOCK
    block_e = jnp.clip(jnp.searchsorted(pends, block_starts, side='right'), 0, N_EXPERTS - 1)

    def expert_block(args):
        e, rows = args
        xb = xf[rows]
        h = xb @ w_gate_up[e] + b_gate_up[e]
        gate, up = h[:, :D_EXPERT], h[:, D_EXPERT:]
        gate = jnp.minimum(gate, SWIGLU_LIMIT)
        up = jnp.clip(up, -SWIGLU_LIMIT, SWIGLU_LIMIT)
        act = (up + 1.0) * gate * jax.nn.sigmoid(SWIGLU_ALPHA * gate)
        return act @ w_down[e] + b_down[e]

    y = lax.map(expert_block, (block_e, buf_tok.reshape(nblk, MOE_BLOCK))).reshape(n_pad, d)
    contrib = jnp.where(buf_valid[:, None], y.astype(jnp.float32) * buf_w[:, None], 0.0)
    out = jnp.zeros((n, d), jnp.float32).at[buf_tok].add(contrib)
    return out.reshape(b, s, d).astype(u.dtype)


def setup_inputs(seed: int = 0) -> dict:
    key = jax.random.key(seed)
    ks = jax.random.split(key, 20)
    f32 = jnp.float32
    nrm = lambda k, shp: jax.random.normal(k, shp, f32)
    L, D, E, F = DEPTH, D_MODEL, N_EXPERTS, D_EXPERT
    return {
        "x": nrm(ks[0], (BATCH, SEQ, D)),
        "c": nrm(ks[1], (BATCH, D)),
        "w_ada": nrm(ks[2], (L, D, N_MOD * D)) * D ** -0.5,
        "b_ada": nrm(ks[3], (L, N_MOD * D)) * 0.02,
        "w_in": nrm(ks[4], (L, D, IN_COLS)) * D ** -0.5,
        "q_norm_g": 1.0 + 0.02 * nrm(ks[5], (L, HEAD_DIM)),
        "k_norm_g": 1.0 + 0.02 * nrm(ks[6], (L, HEAD_DIM)),
        "w_fourier": nrm(ks[7], (L, FOURIER_DIM, D)) * FOURIER_DIM ** -0.5,
        "w_attn_o": nrm(ks[8], (L, Q_DIM, D)) * Q_DIM ** -0.5,
        "w_out": nrm(ks[9], (L, D, D)) * (D ** -0.5 * DEEPNORM_BETA),
        "ln1_g": 1.0 + 0.02 * nrm(ks[10], (L, D)),
        "ln1_b": 0.02 * nrm(ks[11], (L, D)),
        "w_router": nrm(ks[12], (L, D, E)) * D ** -0.5,
        "b_router": nrm(ks[13], (L, E)) * 0.01,
        "w_gate_up": nrm(ks[14], (L, E, D, 2 * F)) * D ** -0.5,
        "b_gate_up": nrm(ks[15], (L, E, 2 * F)) * 0.02,
        "w_down": nrm(ks[16], (L, E, F, D)) * (F ** -0.5 * DEEPNORM_BETA),
        "b_down": nrm(ks[17], (L, E, D)) * 0.02,
        "ln2_g": 1.0 + 0.02 * nrm(ks[18], (L, D)),
        "ln2_b": 0.02 * nrm(ks[19], (L, D)),
    }


def reference(x, c, w_ada, b_ada, w_in, q_norm_g, k_norm_g, w_fourier, w_attn_o, w_out,
              ln1_g, ln1_b, w_router, b_router, w_gate_up, b_gate_up, w_down, b_down,
              ln2_g, ln2_b):
    seq = x.shape[1]
    ang_r, ang_c = axial_rope_angles(seq)
    cond = jax.nn.silu(c)
    for l in range(DEPTH):
        mod = cond @ w_ada[l] + b_ada[l]
        sh1, sc1, g1, sh2, sc2, g2 = [m[:, None, :] for m in jnp.split(mod, N_MOD, axis=-1)]
        u = layer_norm(x, eps=ADA_EPS) * (1.0 + sc1) + sh1
        h = mixing_sublayer(u, w_in[l], q_norm_g[l], k_norm_g[l], w_fourier[l],
                            w_attn_o[l], w_out[l], ang_r, ang_c)
        x = layer_norm(DEEPNORM_ALPHA * x + g1 * h, ln1_g[l], ln1_b[l])
        u = layer_norm(x, eps=ADA_EPS) * (1.0 + sc2) + sh2
        h = moe_sublayer(u, w_router[l], b_router[l], w_gate_up[l], b_gate_up[l],
                         w_down[l], b_down[l])
        x = layer_norm(DEEPNORM_ALPHA * x + g2 * h, ln2_g[l], ln2_b[l])
    return x
```

```cpp
#include <hip/hip_runtime.h>
#include <cstdio>
#include <cstdint>

#ifndef INPROJ_F8
#define INPROJ_F8 1
#endif
#ifndef P5_FUSED
#define P5_FUSED 1
#endif
#ifndef MIX_F8
#define MIX_F8 1
#endif
#ifndef ALIGN_P2
#define ALIGN_P2 true
#endif
#ifndef ALIGN_UP
#define ALIGN_UP true
#endif
#ifndef ALIGN_DN
#define ALIGN_DN true
#endif
#ifndef ALIGN_MIX
#define ALIGN_MIX true
#endif
#define LAS __attribute__((address_space(3)))
#define GAS __attribute__((address_space(1)))
typedef unsigned short bf16_t;
typedef short bf16x8 __attribute__((ext_vector_type(8)));
typedef short s16x4 __attribute__((ext_vector_type(4)));
typedef float f32x2 __attribute__((ext_vector_type(2)));
typedef float f32x4 __attribute__((ext_vector_type(4)));
typedef float f32x16 __attribute__((ext_vector_type(16)));
typedef unsigned u32x2 __attribute__((ext_vector_type(2)));
typedef unsigned u32x4 __attribute__((ext_vector_type(4)));
typedef int i32x8 __attribute__((ext_vector_type(8)));
typedef int i32x6 __attribute__((ext_vector_type(6)));
typedef unsigned u32x6 __attribute__((ext_vector_type(6)));
typedef int i32x4 __attribute__((ext_vector_type(4)));

constexpr int BATCH = 8, SEQ = 8192, D = 1024, NTOK = BATCH * SEQ;
constexpr int NIN = 4608;
constexpr int NE = 32, TOPK = 4, FE = 1024;
constexpr int NHALF = 1, HTOK = NTOK / NHALF;
constexpr int MAXROWS_H = HTOK * TOPK + NE * 256;
constexpr int MAXTILES_H = MAXROWS_H / 256;
constexpr float DN_ALPHA = 1.189207115002721f;
constexpr int NWAVES = 8, NTHR = 512;

constexpr size_t MiB = 1u << 20;
constexpr size_t WS_CTL = 0, CTL_ZERO_BYTES = 64 * 1024;
constexpr size_t WS_MOD = 1 * MiB;
constexpr size_t WS_ROPE_R = WS_MOD + 256 * 1024;
constexpr size_t WS_ROPE_C = WS_ROPE_R + 32 * 1024;
constexpr size_t WS_M1 = WS_ROPE_C + 16 * 1024;
constexpr size_t WS_HIST = WS_M1 + 32 * 1024;
constexpr size_t WS_ST1 = 1 * MiB + 512 * 1024;
constexpr size_t WS_TILEE = WS_HIST + 32 * 1024;
constexpr size_t WS_ETAB = 2 * MiB;
constexpr size_t WS_WIN = 6 * MiB;
constexpr size_t WS_WF = 15 * MiB;
constexpr size_t WS_WAO = 16 * MiB;
constexpr size_t WS_WOUT = 18 * MiB;
constexpr size_t WS_WGU = 20 * MiB;
constexpr size_t WS_WD = 84 * MiB;
constexpr size_t WS_TOPE = 116 * MiB;
constexpr size_t WS_TOPW = 117 * MiB;
constexpr size_t WS_RANK = 118 * MiB;
constexpr size_t WS_ROWTOK = 119 * MiB;
constexpr size_t WS_ROWDST = 120 * MiB + 512 * 1024;
constexpr size_t WS_ROWW = 122 * MiB;
constexpr size_t WS_U2 = 124 * MiB;
constexpr size_t WS_U = 188 * MiB;
constexpr size_t WS_H = 316 * MiB;
constexpr size_t WS_Q = 444 * MiB;
constexpr size_t WS_K = 572 * MiB;
constexpr size_t WS_V = 604 * MiB;
constexpr size_t WS_G = 636 * MiB;
constexpr size_t WS_KF8 = 892 * MiB;
constexpr size_t WS_VT8 = 908 * MiB;
constexpr size_t WS_K6 = 924 * MiB;
constexpr size_t WS_T = WS_H;
constexpr size_t WS_ACT = 188 * MiB;
constexpr size_t WS_YB = 452 * MiB;
constexpr size_t WS_END = 964 * MiB;
static_assert(WS_ROWTOK + (size_t)MAXROWS_H * 4 <= WS_ROWDST && WS_ROWDST + (size_t)MAXROWS_H * 4 <= WS_ROWW && WS_ROWW + (size_t)MAXROWS_H * 4 <= WS_U2, "routing tables");
static_assert(WS_ACT + (size_t)MAXROWS_H * 1024 <= WS_YB && WS_YB + (size_t)HTOK * 4 * 1024 * 2 <= WS_END && WS_G + (size_t)NTOK * 2048 * 2 <= WS_END, "moe overlay");
constexpr int CW_BAR = 1024;

constexpr int RING_BYTES = 131072;
constexpr int LDS_BYTES = 147456;
constexpr int MISC_OFF = LDS_BYTES - 256;

#define LDS_WAIT() asm volatile("s_waitcnt lgkmcnt(0)" ::: "memory")
#define VM_WAIT() asm volatile("s_waitcnt vmcnt(0)" ::: "memory")
typedef __bf16 bf16x2_t __attribute__((ext_vector_type(2)));
__device__ __forceinline__ unsigned cvt_pk_bf16(float lo, float hi) { f32x2 v = {lo, hi}; bf16x2_t b = __builtin_convertvector(v, bf16x2_t); return __builtin_bit_cast(unsigned, b); }
__device__ __forceinline__ float clamp_f8(float v) { return __builtin_amdgcn_fmed3f(v, -448.0f, 448.0f); }
__device__ __forceinline__ unsigned pack4_fp8_nc(float a, float b, float c, float d) { int w = __builtin_amdgcn_cvt_pk_fp8_f32(a, b, 0, false); w = __builtin_amdgcn_cvt_pk_fp8_f32(c, d, w, true); return (unsigned)w; }
__device__ __forceinline__ unsigned pack4_fp8(float a, float b, float c, float d) { int w = __builtin_amdgcn_cvt_pk_fp8_f32(clamp_f8(a), clamp_f8(b), 0, false); w = __builtin_amdgcn_cvt_pk_fp8_f32(clamp_f8(c), clamp_f8(d), w, true); return (unsigned)w; }
__device__ __forceinline__ float bf_lo(unsigned w) { return __uint_as_float(w << 16); }
__device__ __forceinline__ float bf_hi(unsigned w) { return __uint_as_float(w & 0xffff0000u); }
__device__ __forceinline__ float sigmoidf_(float x) { return __builtin_amdgcn_rcpf(1.0f + __builtin_amdgcn_exp2f(-1.4426950408889634f * x)); }
__device__ __forceinline__ int tid_fresh() { int t = threadIdx.x; asm volatile("" : "+v"(t)); return t; }
__device__ __forceinline__ void wave_sum2(float& a, float& b) {
#pragma unroll
    for (int o = 1; o < 64; o <<= 1) { const float ta = __shfl_xor(a, o), tb = __shfl_xor(b, o); a += ta; b += tb; }
}
__device__ __forceinline__ float wave_sum(float v) {
#pragma unroll
    for (int o = 1; o < 64; o <<= 1) v += __shfl_xor(v, o);
    return v;
}

#define XB_TMO      128
#define XB_XCNT(j)  (256  + 64 * (j))
#define XB_XSUB(j)  (1280 + 64 * (j))
#define XB_XGEN(j)  (2304 + 64 * (j))
#define XB_TOP      3328
#define XB_TOPGEN   3392
#define XCD_BAR_WORDS 3456
#define XB_SPIN_CAP (1u << 18)
__device__ __forceinline__ unsigned xb_ld(unsigned* p)              { return __hip_atomic_load(p, __ATOMIC_RELAXED, __HIP_MEMORY_SCOPE_AGENT); }
__device__ __forceinline__ unsigned xb_add(unsigned* p, unsigned v) { return __hip_atomic_fetch_add(p, v, __ATOMIC_RELAXED, __HIP_MEMORY_SCOPE_AGENT); }
__device__ __forceinline__ unsigned xb_xcc_id() { return (unsigned)__builtin_amdgcn_s_getreg((3 << 11) | 20) & 0xFu; }
#define XB_SPIN(cond, bar) do { unsigned _sp = 0; while (cond) { __builtin_amdgcn_s_sleep(1); \
    if ((++_sp & 255u) == 0u) { if (xb_ld(&(bar)[XB_TMO])) break; if (_sp > XB_SPIN_CAP) { atomicAdd(&(bar)[XB_TMO], 1u); break; } } } } while (0)
struct XcdBarrier { unsigned* bar; unsigned x; volatile LAS unsigned* st; };
__device__ __forceinline__ XcdBarrier xcd_barrier_post(unsigned* bar, volatile LAS unsigned* st) {
    XcdBarrier b; b.bar = bar; b.x = xb_xcc_id(); b.st = st;
    if (threadIdx.x == 0) (void)xb_add(&bar[XB_XCNT(b.x)], 1u);
    return b;
}
__device__ __forceinline__ void xcd_barrier_complete(unsigned* bar, unsigned x, unsigned& nloc, unsigned& nx) {
    const unsigned G = gridDim.x * gridDim.y * gridDim.z;
    unsigned sum, cnt, mine, sp = 0u;
    for (;;) {
        sum = 0u; cnt = 0u; mine = 0u;
#pragma unroll
        for (unsigned j = 0; j < 16; ++j) { const unsigned c = xb_ld(&bar[XB_XCNT(j)]); sum += c; cnt += (c > 0u) ? 1u : 0u; mine = (j == x) ? c : mine; }
        if (sum == G) break;
        __builtin_amdgcn_s_sleep(1);
        if ((++sp & 255u) == 0u) { if (xb_ld(&bar[XB_TMO])) break; if (sp > XB_SPIN_CAP) { atomicAdd(&bar[XB_TMO], 1u); break; } }
    }
    nloc = mine > 0u ? mine : 1u; nx = cnt > 0u ? cnt : 1u;
}
__device__ __forceinline__ void xcd_barrier(const XcdBarrier& b) {
    asm volatile("s_waitcnt vmcnt(0)" ::: "memory");
    __syncthreads();
    if (threadIdx.x == 0) {
        unsigned* bar = b.bar;
        __builtin_amdgcn_s_waitcnt(0);
        unsigned nloc = b.st[0], nx = b.st[1];
        if (nloc == 0u) { xcd_barrier_complete(bar, b.x, nloc, nx); b.st[0] = nloc; b.st[1] = nx; }
        const unsigned old = xb_add(&bar[XB_XSUB(b.x)], 1u);
        const unsigned gen = old / nloc;
        if (old + 1u == (gen + 1u) * nloc) {
            __builtin_amdgcn_fence(__ATOMIC_RELEASE, "agent");
            asm volatile("s_waitcnt vmcnt(0)" ::: "memory");
            const unsigned og = xb_add(&bar[XB_TOP], 1u);
            const unsigned tg = og / nx;
            if (og + 1u == (tg + 1u) * nx) xb_add(&bar[XB_TOPGEN], 1u);
            else XB_SPIN(xb_ld(&bar[XB_TOPGEN]) == tg, bar);
            __builtin_amdgcn_fence(__ATOMIC_ACQUIRE, "agent");
            xb_add(&bar[XB_XGEN(b.x)], 1u);
            asm volatile("s_waitcnt vmcnt(0)" ::: "memory");
        } else {
            XB_SPIN(xb_ld(&bar[XB_XGEN(b.x)]) == gen, bar);
            __builtin_amdgcn_fence(__ATOMIC_ACQUIRE, "agent");
            asm volatile("s_waitcnt vmcnt(0)" ::: "memory");
        }
    }
    __syncthreads();
}

namespace pg8 {
constexpr int BM = 256, BK = 64, HALF = 128, HTB = HALF * BK * 2, NXCD = 8, WGM = 8;
__host__ __device__ __forceinline__ int lds_byte(int r, int c) { const int st = (r >> 4) * 2 + (c >> 5), rr = r & 15, cc = c & 31, ob = rr * 64 + cc * 2; return st * 1024 + (ob ^ (((ob >> 9) & 1) << 5)); }
__host__ __device__ __forceinline__ void stage_rc(int b, int& R, int& C) { const int st = b / 1024, sb = b % 1024, swz = sb ^ (((sb >> 9) & 1) << 5); R = (st >> 1) * 16 + swz / 64; C = (st & 1) * 32 + (swz % 64) / 2; }
__host__ __device__ __forceinline__ int perm32(int rho) { const int n = rho >> 4, i = rho & 15; return 8 * (i >> 2) + 4 * n + (i & 3); }

struct Unit { int pm, pn, e; size_t bofs; };
struct Gemm { const bf16_t* A; const bf16_t* Bt; const int* rowtab; int K; };

__device__ __forceinline__ bool tile_order(int i, int G, int c, int nM, int nN, int& pm, int& pn) {
    const int nwg = nM * nN; const long L = (long)i * G + c; if (L >= nwg) return false;
    int wgid = (int)L; { const int q = nwg / NXCD, r = nwg % NXCD, xcd = wgid % NXCD, off = wgid / NXCD; wgid = (xcd < r ? xcd * (q + 1) : r * (q + 1) + (xcd - r) * q) + off; }
    const int nig = WGM * nN, gid = wgid / nig, fm = gid * WGM, gsz = (nM - fm) < WGM ? (nM - fm) : WGM;
    pm = fm + ((wgid % nig) % gsz); pn = (wgid % nig) / gsz; return true;
}
struct DenseOrder {
    int nM, nN, G, c, K;
    __device__ __forceinline__ bool next(int i, Unit& u) const { if (!tile_order(i, G, c, nM, nN, u.pm, u.pn)) return false; u.e = 0; u.bofs = (size_t)u.pn * 256 * K; return true; }
};
struct MoeOrder {
    int nM, nN, G, c, K; const int* tile_e; size_t estride;
    __device__ __forceinline__ bool next(int i, Unit& u) const { if (!tile_order(i, G, c, nM, nN, u.pm, u.pn)) return false;
        u.e = __builtin_amdgcn_readfirstlane(tile_e[u.pm]); u.bofs = (size_t)u.e * estride + (size_t)u.pn * 256 * K; return true; }
};

template <class Epi, class Sched, bool GATHER, bool ALIGN_EPI = true, bool F8 = false>
__device__ __forceinline__ void gemm_phase(LAS unsigned char* lds, const Gemm g, const Sched& S, const Epi& E) {
    const int tid = tid_fresh(), wid = __builtin_amdgcn_readfirstlane(tid >> 6), lane = tid & 63, wr = wid >> 2, wc = wid & 3, fr = lane & 15, fq = lane >> 4;
    const int K = g.K, KB = F8 ? K : 2 * K, nt = KB / 128;
    int Rl[2], Cl[2]; unsigned voffB[2];
#pragma unroll
    for (int i = 0; i < 2; ++i) { int R, C; stage_rc(tid * 16 + i * 8192, R, C); Rl[i] = R;
        { const int jp = C >> 3; Cl[i] = F8 ? (2 * (jp & 3) + (jp >> 2)) * 16 : C * 2; }
        const int Rb = (R & ~31) + perm32(R & 31); voffB[i] = (unsigned)(Rb * KB + Cl[i]); }
    const size_t kstep = (size_t)128;
    const size_t hstep = (size_t)HALF * KB;
    const unsigned ldsw = (unsigned)wid * 1024u;
    const int aoff = lds_byte(wr * 64 + fr, fq * 8), boff = lds_byte(wc * 32 + fr, fq * 8);
#define PG8_SA(b, h) (((b) * 2 + (h)) * HTB)
#define PG8_SB(b, h) ((4 + (b) * 2 + (h)) * HTB)
#define PG8_STAGE(bufoff, gbase, v0, v1) do { \
        __builtin_amdgcn_global_load_lds((const unsigned*)((const char*)(gbase) + (v0)), (LAS unsigned*)(lds + (bufoff) + ldsw), 16, 0, 0); \
        __builtin_amdgcn_global_load_lds((const unsigned*)((const char*)(gbase) + (v1)), (LAS unsigned*)(lds + (bufoff) + ldsw + 8192), 16, 0, 0); } while (0)
#define PG8_LD8(p) __builtin_shufflevector(*(const LAS i32x4*)(p), *(const LAS i32x4*)((p) + 1024), 0, 1, 2, 3, 4, 5, 6, 7)
#define PG8_LDA(dst, b, h) do { _Pragma("unroll") for (int m = 0; m < 4; ++m) dst[m] = PG8_LD8(lds + PG8_SA(b, h) + aoff + m * 2048); } while (0)
#define PG8_LDB(dst, b, h) do { _Pragma("unroll") for (int n = 0; n < 2; ++n) dst[n] = PG8_LD8(lds + PG8_SB(b, h) + boff + n * 2048); } while (0)
#define PG8_LO(x) __builtin_bit_cast(bf16x8, __builtin_shufflevector((x), (x), 0, 1, 2, 3))
#define PG8_HI(x) __builtin_bit_cast(bf16x8, __builtin_shufflevector((x), (x), 4, 5, 6, 7))
#define PG8_MMA(ai, bj, At, Bt) do { __builtin_amdgcn_s_setprio(1); \
        if constexpr (F8) { _Pragma("unroll") for (int m = 0; m < 4; ++m) _Pragma("unroll") for (int n = 0; n < 2; ++n) \
            asm volatile("v_mfma_scale_f32_16x16x128_f8f6f4 %0, %1, %2, %0, %3, %3 op_sel_hi:[0,0,0]" : "+v"(acc[ai][bj][m][n]) : "v"(Bt[n]), "v"(At[m]), "v"(f8scale)); } \
        else { _Pragma("unroll") for (int m = 0; m < 4; ++m) _Pragma("unroll") for (int n = 0; n < 2; ++n) { \
            acc[ai][bj][m][n] = __builtin_amdgcn_mfma_f32_16x16x32_bf16(PG8_LO(Bt[n]), PG8_LO(At[m]), acc[ai][bj][m][n], 0, 0, 0); \
            acc[ai][bj][m][n] = __builtin_amdgcn_mfma_f32_16x16x32_bf16(PG8_HI(Bt[n]), PG8_HI(At[m]), acc[ai][bj][m][n], 0, 0, 0); } } \
        __builtin_amdgcn_s_setprio(0); } while (0)
#define PG8_WAIT_V(n) asm volatile("s_waitcnt vmcnt(" #n ")" ::: "memory")
#define PG8_WAIT_L(n) asm volatile("s_waitcnt lgkmcnt(" #n ")" ::: "memory")
#define PG8_BAR __builtin_amdgcn_s_barrier()
#define PG8_SCHED __builtin_amdgcn_sched_barrier(0)
#define PG8_AOFFS(u, v) do { _Pragma("unroll") for (int h_ = 0; h_ < 2; ++h_) _Pragma("unroll") for (int i_ = 0; i_ < 2; ++i_) { \
        int row_ = (u).pm * BM + h_ * HALF + Rl[i_]; if (GATHER) row_ = g.rowtab[row_]; (v)[h_][i_] = (unsigned)(row_ * KB + Cl[i_]); } } while (0)
    Unit cur, nxt; int ui = 0;
    if (!S.next(0, cur)) return;
    f32x4 acc[2][2][4][2];
#pragma unroll
    for (int a = 0; a < 2; ++a)
#pragma unroll
        for (int b = 0; b < 2; ++b)
#pragma unroll
            for (int m = 0; m < 4; ++m)
#pragma unroll
                for (int n = 0; n < 2; ++n) acc[a][b][m][n] = (f32x4){0.f, 0.f, 0.f, 0.f};
    i32x8 At[4], B0[2], B1[2];
    const int f8scale = 0x7f7f7f7f;
    unsigned cv[2][2], nv[2][2];
    PG8_AOFFS(cur, cv);
    E.unit_begin(cur, lds, wid, lane, 0);
    const char* const Ab = (const char*)g.A;
    const char* cB = (const char*)g.Bt + cur.bofs;
    PG8_STAGE(PG8_SB(0, 0), cB, voffB[0], voffB[1]); PG8_STAGE(PG8_SB(0, 1), cB + hstep, voffB[0], voffB[1]); PG8_STAGE(PG8_SA(0, 0), Ab, cv[0][0], cv[0][1]); PG8_STAGE(PG8_SA(0, 1), Ab, cv[1][0], cv[1][1]);
    if (wr == 1) PG8_BAR;
    PG8_WAIT_V(2); PG8_BAR;
    PG8_STAGE(PG8_SB(1, 0), cB + kstep, voffB[0], voffB[1]); PG8_STAGE(PG8_SA(1, 0), Ab + kstep, cv[0][0], cv[0][1]); PG8_STAGE(PG8_SB(1, 1), cB + hstep + kstep, voffB[0], voffB[1]);
    PG8_WAIT_V(6); PG8_BAR;
    for (;;) {
        const bool has_next = S.next(ui + 1, nxt);
        if (has_next) { PG8_AOFFS(nxt, nv); } else {
#pragma unroll
            for (int h_ = 0; h_ < 2; ++h_)
#pragma unroll
                for (int i_ = 0; i_ < 2; ++i_) nv[h_][i_] = cv[h_][i_]; }
        const char* nB = has_next ? (const char*)g.Bt + nxt.bofs : cB;
#pragma unroll 1
        for (int t = 0; t < nt; t += 2) {
            const bool last = (t == nt - 2);
            const char* a1 = Ab + (size_t)(t + 1) * kstep;
            const char* a2 = last ? Ab : Ab + (size_t)(t + 2) * kstep; const char* b2 = last ? nB : cB + (size_t)(t + 2) * kstep;
            const char* a3 = a2 + kstep; const char* b3 = b2 + kstep;
            const unsigned s00 = last ? nv[0][0] : cv[0][0], s01 = last ? nv[0][1] : cv[0][1], s10 = last ? nv[1][0] : cv[1][0], s11 = last ? nv[1][1] : cv[1][1];
            PG8_LDB(B0, 0, 0); PG8_LDB(B1, 0, 1); PG8_SCHED; PG8_LDA(At, 0, 0); PG8_STAGE(PG8_SA(1, 1), a1, cv[1][0], cv[1][1]);
            PG8_WAIT_V(8); PG8_WAIT_L(0); PG8_BAR; PG8_MMA(0, 0, At, B0); PG8_MMA(0, 1, At, B1); PG8_BAR; PG8_SCHED;
            PG8_LDA(At, 0, 1); PG8_STAGE(PG8_SB(0, 0), b2, voffB[0], voffB[1]); PG8_STAGE(PG8_SB(0, 1), b2 + hstep, voffB[0], voffB[1]); PG8_STAGE(PG8_SA(0, 0), a2, s00, s01);
            PG8_WAIT_V(8); PG8_WAIT_L(0); PG8_BAR; PG8_MMA(1, 0, At, B0); PG8_MMA(1, 1, At, B1); PG8_BAR; PG8_SCHED;
            PG8_LDB(B0, 1, 0); PG8_LDB(B1, 1, 1); PG8_SCHED; PG8_LDA(At, 1, 0); PG8_STAGE(PG8_SA(0, 1), a2, s10, s11);
            PG8_WAIT_V(8); PG8_WAIT_L(0); PG8_BAR; PG8_MMA(0, 0, At, B0); PG8_MMA(0, 1, At, B1); PG8_BAR; PG8_SCHED;
            PG8_LDA(At, 1, 1); PG8_STAGE(PG8_SB(1, 0), b3, voffB[0], voffB[1]); PG8_STAGE(PG8_SB(1, 1), b3 + hstep, voffB[0], voffB[1]); PG8_STAGE(PG8_SA(1, 0), a3, s00, s01);
            PG8_WAIT_V(8); PG8_WAIT_L(0); PG8_BAR; PG8_MMA(1, 0, At, B0); PG8_MMA(1, 1, At, B1); PG8_BAR; PG8_SCHED;
        }
        if (ALIGN_EPI) { if (wr == 0) PG8_BAR; }
        if constexpr (F8) asm volatile("s_nop 15\n\ts_nop 15\n\ts_nop 15" ::: "memory");
        if constexpr (Epi::NEEDS_LDS) E.run(acc, cur, wr, wc, fr, fq, lds, ui); else E(acc, cur, wr, wc, fr, fq);
        if (!has_next) break;
#pragma unroll
        for (int a = 0; a < 2; ++a)
#pragma unroll
            for (int b = 0; b < 2; ++b)
#pragma unroll
                for (int m = 0; m < 4; ++m)
#pragma unroll
                    for (int n = 0; n < 2; ++n) acc[a][b][m][n] = (f32x4){0.f, 0.f, 0.f, 0.f};
        cur = nxt; cB = nB; ++ui;
        E.unit_begin(cur, lds, wid, lane, ui);
#pragma unroll
        for (int h_ = 0; h_ < 2; ++h_)
#pragma unroll
            for (int i_ = 0; i_ < 2; ++i_) cv[h_][i_] = nv[h_][i_];
        if (ALIGN_EPI) { if (wr == 1) PG8_BAR; }
    }
    PG8_WAIT_V(0);
    if (!ALIGN_EPI) { if (wr == 0) PG8_BAR; }
    PG8_BAR;
#undef PG8_SA
#undef PG8_SB
#undef PG8_STAGE
#undef PG8_LDA
#undef PG8_LDB
#undef PG8_MMA
#undef PG8_LO
#undef PG8_HI
#undef PG8_LD8
#undef PG8_WAIT_V
#undef PG8_WAIT_L
#undef PG8_BAR
#undef PG8_SCHED
#undef PG8_AOFFS
}

#define EPI_FOREACH(acc, wr, wc, fr, fq, ...) \
    _Pragma("unroll") for (int ai = 0; ai < 2; ++ai) _Pragma("unroll") for (int m = 0; m < 4; ++m) { const int rt_ = ai * 128 + wr * 64 + m * 16 + fr; \
        _Pragma("unroll") for (int bj = 0; bj < 2; ++bj) { const int ct_ = bj * 128 + wc * 32 + 8 * fq; const f32x4 v0 = acc[ai][bj][m][0], v1 = acc[ai][bj][m][1]; __VA_ARGS__ } }

__device__ __forceinline__ u32x4 pack8(f32x4 a, f32x4 b) { u32x4 w; w.x = cvt_pk_bf16(a[0], a[1]); w.y = cvt_pk_bf16(a[2], a[3]); w.z = cvt_pk_bf16(b[0], b[1]); w.w = cvt_pk_bf16(b[2], b[3]); return w; }
__device__ __forceinline__ void unpack8(u32x4 w, f32x4& a, f32x4& b) { a = (f32x4){bf_lo(w.x), bf_hi(w.x), bf_lo(w.y), bf_hi(w.y)}; b = (f32x4){bf_lo(w.z), bf_hi(w.z), bf_lo(w.w), bf_hi(w.w)}; }
__device__ __forceinline__ f32x4 sig4(f32x4 v) { return (f32x4){sigmoidf_(v[0]), sigmoidf_(v[1]), sigmoidf_(v[2]), sigmoidf_(v[3])}; }

#define EPI_NOHOOK static constexpr bool NEEDS_LDS = false; __device__ __forceinline__ void unit_begin(const Unit&, LAS unsigned char*, int, int, int) const {} \
    __device__ __forceinline__ void run(const f32x4 (&)[2][2][4][2], const Unit&, int, int, int, int, LAS unsigned char*, int) const {}
struct EpiInProj { EPI_NOHOOK
    bf16_t *Hb, *Qb, *Kb, *Vb, *Gb; float osc;
    __device__ __forceinline__ void operator()(const f32x4 (&acc)[2][2][4][2], const Unit& u, int wr, int wc, int fr, int fq) const {
        bf16_t* base; int ld, colt; bool sg = false;
        if (u.pn < 4) { base = Hb; ld = 1024; colt = u.pn * 256; }
        else if (u.pn < 8) { base = Qb; ld = 1024; colt = (u.pn - 4) * 256; }
        else if (u.pn == 8) { base = Kb; ld = 256; colt = 0; }
        else if (u.pn == 9) { base = Vb; ld = 256; colt = 0; }
        else { base = Gb; ld = 2048; colt = (u.pn - 10) * 256; sg = true; }
        EPI_FOREACH(acc, wr, wc, fr, fq, {
            f32x4 a = v0 * osc, b = v1 * osc; if (sg) { a = sig4(a); b = sig4(b); }
            *(u32x4*)(base + (size_t)(u.pm * 256 + rt_) * ld + colt + ct_) = pack8(a, b); })
    }
};
struct EpiGateF { EPI_NOHOOK
    const bf16_t* Gb; bf16_t* tmp;
    __device__ __forceinline__ void operator()(const f32x4 (&acc)[2][2][4][2], const Unit& u, int wr, int wc, int fr, int fq) const {
        EPI_FOREACH(acc, wr, wc, fr, fq, {
            const size_t row = (size_t)(u.pm * 256 + rt_); const int col = u.pn * 256 + ct_;
            f32x4 ga, gb; unpack8(*(const u32x4*)(Gb + row * 2048 + col), ga, gb);
            *(u32x4*)(tmp + row * 1024 + col) = pack8(ga * v0, gb * v1); })
    }
};
struct EpiGateA { EPI_NOHOOK
    const bf16_t* Gb; const bf16_t* tmp; bf16_t* Mb;
    __device__ __forceinline__ void operator()(const f32x4 (&acc)[2][2][4][2], const Unit& u, int wr, int wc, int fr, int fq) const {
        EPI_FOREACH(acc, wr, wc, fr, fq, {
            const size_t row = (size_t)(u.pm * 256 + rt_); const int col = u.pn * 256 + ct_;
            f32x4 ga, gb; unpack8(*(const u32x4*)(Gb + row * 2048 + 1024 + col), ga, gb);
            f32x4 t0, t1; unpack8(*(const u32x4*)(tmp + row * 1024 + col), t0, t1);
            *(u32x4*)(Mb + row * 1024 + col) = pack8(t0 + ga * v0, t1 + gb * v1); })
    }
};
struct EpiOut { EPI_NOHOOK
    const float* x; const float* mod; float* pre; float osc;
    __device__ __forceinline__ void operator()(const f32x4 (&acc)[2][2][4][2], const Unit& u, int wr, int wc, int fr, int fq) const {
        const float* g1 = mod + (size_t)((u.pm * 256) / SEQ) * 6144 + 2 * 1024 + u.pn * 256 + wc * 32 + 8 * fq;
        f32x4 gA[2], gB[2];
#pragma unroll
        for (int bj = 0; bj < 2; ++bj) { gA[bj] = *(const f32x4*)(g1 + bj * 128) * osc; gB[bj] = *(const f32x4*)(g1 + bj * 128 + 4) * osc; }
#pragma unroll
        for (int ai = 0; ai < 2; ++ai) { f32x4 xa[4][2], xb[4][2];
#pragma unroll
            for (int m = 0; m < 4; ++m) { const size_t row = (size_t)(u.pm * 256 + ai * 128 + wr * 64 + m * 16 + fr);
#pragma unroll
                for (int bj = 0; bj < 2; ++bj) { const int col = u.pn * 256 + bj * 128 + wc * 32 + 8 * fq; xa[m][bj] = *(const f32x4*)(x + row * 1024 + col); xb[m][bj] = *(const f32x4*)(x + row * 1024 + col + 4); } }
            __builtin_amdgcn_sched_barrier(0);
#pragma unroll
            for (int m = 0; m < 4; ++m) { const size_t row = (size_t)(u.pm * 256 + ai * 128 + wr * 64 + m * 16 + fr);
#pragma unroll
                for (int bj = 0; bj < 2; ++bj) { const int col = u.pn * 256 + bj * 128 + wc * 32 + 8 * fq;
                    *(u32x4*)((bf16_t*)(pre + row * 1024) + col) = pack8(xa[m][bj] * DN_ALPHA + gA[bj] * acc[ai][bj][m][0], xb[m][bj] * DN_ALPHA + gB[bj] * acc[ai][bj][m][1]); } }
            __builtin_amdgcn_sched_barrier(0); }
    }
};
struct EpiSwiglu { EPI_NOHOOK
    const float* bgu; unsigned char* act;
    __device__ __forceinline__ void operator()(const f32x4 (&acc)[2][2][4][2], const Unit& u, int wr, int wc, int fr, int fq) const {
        const float* bg = bgu + (size_t)u.e * 2048 + u.pn * 128 + wc * 32 + 8 * fq; const float* bu = bg + 1024;
        const f32x4 bg0 = *(const f32x4*)bg, bg1 = *(const f32x4*)(bg + 4), bu0 = *(const f32x4*)bu, bu1 = *(const f32x4*)(bu + 4);
#pragma unroll
        for (int ai = 0; ai < 2; ++ai)
#pragma unroll
            for (int m = 0; m < 4; ++m) {
                const size_t row = (size_t)(u.pm * 256 + ai * 128 + wr * 64 + m * 16 + fr);
                f32x4 r[2];
#pragma unroll
                for (int n = 0; n < 2; ++n) {
                    const f32x4 gt = acc[ai][0][m][n] * 0.03125f + (n ? bg1 : bg0), up = acc[ai][1][m][n] * 0.03125f + (n ? bu1 : bu0);
#pragma unroll
                    for (int j = 0; j < 4; ++j) { const float gc = fminf(gt[j], 7.0f), uc = fminf(fmaxf(up[j], -7.0f), 7.0f);
                        r[n][j] = fmaf(uc, gc, gc) * __builtin_amdgcn_rcpf(1.0f + __builtin_amdgcn_exp2f(-2.4554669595930156f * gc)); }
                }
                *(u32x2*)(act + row * 1024 + u.pn * 128 + wc * 32 + 8 * fq) = (u32x2){pack4_fp8_nc(r[0][0], r[0][1], r[0][2], r[0][3]), pack4_fp8_nc(r[1][0], r[1][1], r[1][2], r[1][3])};
            }
    }
};
struct EpiDown {
    const float* bd; const int* rowdst; const float* roww; bf16_t* yb;
    static constexpr int TAB = 131072;
    __device__ __forceinline__ void unit_begin(const Unit& u, LAS unsigned char* lds, int wid, int lane, int ui) const {
        if (wid == 0) { const unsigned base = (unsigned)(uintptr_t)lds + TAB + (ui & 1) * 2048;
            __builtin_amdgcn_global_load_lds((const unsigned*)(rowdst + u.pm * 256 + lane * 4), (LAS unsigned*)(base), 16, 0, 0);
            __builtin_amdgcn_global_load_lds((const unsigned*)(roww + u.pm * 256 + lane * 4), (LAS unsigned*)(base + 1024), 16, 0, 0); }
    }
    __device__ __forceinline__ void run(const f32x4 (&acc)[2][2][4][2], const Unit& u, int wr, int wc, int fr, int fq, LAS unsigned char* lds, int ui) const {
        const float* bb = bd + (size_t)u.e * 1024 + u.pn * 256 + wc * 32 + 8 * fq;
        const LAS int* tdst = (const LAS int*)(lds + TAB + (ui & 1) * 2048); const LAS float* tw = (const LAS float*)(lds + TAB + (ui & 1) * 2048 + 1024);
        f32x4 b0[2], b1[2];
#pragma unroll
        for (int bj = 0; bj < 2; ++bj) { b0[bj] = *(const f32x4*)(bb + bj * 128); b1[bj] = *(const f32x4*)(bb + bj * 128 + 4); }
        int dsts[2][4]; float wts[2][4];
#pragma unroll
        for (int ai = 0; ai < 2; ++ai)
#pragma unroll
            for (int m = 0; m < 4; ++m) { const int rl = ai * 128 + wr * 64 + m * 16 + fr; dsts[ai][m] = tdst[rl]; wts[ai][m] = tw[rl]; }
        __builtin_amdgcn_s_waitcnt(0x0070); __builtin_amdgcn_sched_barrier(0);
#pragma unroll
        for (int ai = 0; ai < 2; ++ai)
#pragma unroll
            for (int m = 0; m < 4; ++m) {
                const int dst = dsts[ai][m]; const float w = wts[ai][m];
                if (dst >= 0) {
#pragma unroll
                    for (int bj = 0; bj < 2; ++bj)
                        *(u32x4*)(yb + (size_t)dst * 1024 + u.pn * 256 + bj * 128 + wc * 32 + 8 * fq) = pack8((acc[ai][bj][m][0] * 0.03125f + b0[bj]) * w, (acc[ai][bj][m][1] * 0.03125f + b1[bj]) * w);
                }
            }
    }
    static constexpr bool NEEDS_LDS = true;
    __device__ __forceinline__ void operator()(const f32x4 (&)[2][2][4][2], const Unit&, int, int, int, int) const {}
};

__device__ __forceinline__ void gemm_p5_fused(LAS unsigned char* lds, const bf16_t* Yb, const bf16_t* Wft, const bf16_t* Ob, const bf16_t* Waot, const bf16_t* Gb, bf16_t* Mb, int G, int c) {
    const int tid = tid_fresh(), wid = __builtin_amdgcn_readfirstlane(tid >> 6), lane = tid & 63, wr = wid >> 2, wc = wid & 3, fr = lane & 15, fq = lane >> 4;
    constexpr int KB0 = MIX_F8 ? 512 : 1024, KB1 = MIX_F8 ? 1024 : 2048, NT0 = KB0 / 128, NT1 = KB1 / 128;
    int Rl[2], Cl[2], Rb[2];
#pragma unroll
    for (int i = 0; i < 2; ++i) { int R, C; stage_rc(tid * 16 + i * 8192, R, C); Rl[i] = R; { const int jp = C >> 3; Cl[i] = MIX_F8 ? (2 * (jp & 3) + (jp >> 2)) * 16 : C * 2; } Rb[i] = (R & ~31) + perm32(R & 31); }
    const int f8scale = 0x7f7f7f7f;
#define P5_AO(pm_, KB_, h_, i_) ((unsigned)((((pm_) * BM + (h_) * HALF + Rl[i_]) * (KB_)) + Cl[i_]))
#define P5_BO(KB_, i_) ((unsigned)(Rb[i_] * (KB_) + Cl[i_]))
    const unsigned ldsw = (unsigned)wid * 1024u;
    const int aoff = lds_byte(wr * 64 + fr, fq * 8), boff = lds_byte(wc * 32 + fr, fq * 8);
#define PG8_SA(b, h) (((b) * 2 + (h)) * HTB)
#define PG8_SB(b, h) ((4 + (b) * 2 + (h)) * HTB)
#define PG8_STAGE(bufoff, gbase, v0, v1) do { \
        __builtin_amdgcn_global_load_lds((const unsigned*)((const char*)(gbase) + (v0)), (LAS unsigned*)(lds + (bufoff) + ldsw), 16, 0, 0); \
        __builtin_amdgcn_global_load_lds((const unsigned*)((const char*)(gbase) + (v1)), (LAS unsigned*)(lds + (bufoff) + ldsw + 8192), 16, 0, 0); } while (0)
#define PG8_LD8(p) __builtin_shufflevector(*(const LAS i32x4*)(p), *(const LAS i32x4*)((p) + 1024), 0, 1, 2, 3, 4, 5, 6, 7)
#define PG8_LDA(dst, b, h) do { _Pragma("unroll") for (int m = 0; m < 4; ++m) dst[m] = PG8_LD8(lds + PG8_SA(b, h) + aoff + m * 2048); } while (0)
#define PG8_LDB(dst, b, h) do { _Pragma("unroll") for (int n = 0; n < 2; ++n) dst[n] = PG8_LD8(lds + PG8_SB(b, h) + boff + n * 2048); } while (0)
#define PG8_LO(x) __builtin_bit_cast(bf16x8, __builtin_shufflevector((x), (x), 0, 1, 2, 3))
#define PG8_HI(x) __builtin_bit_cast(bf16x8, __builtin_shufflevector((x), (x), 4, 5, 6, 7))
#define PG8_MMA(ai, bj, At, Bt) do { __builtin_amdgcn_s_setprio(1); _Pragma("unroll") for (int m = 0; m < 4; ++m) _Pragma("unroll") for (int n = 0; n < 2; ++n) { \
            if constexpr (MIX_F8 != 0) { asm volatile("v_mfma_scale_f32_16x16x128_f8f6f4 %0, %1, %2, %0, %3, %3 op_sel_hi:[0,0,0]" : "+v"(acc[ai][bj][m][n]) : "v"(Bt[n]), "v"(At[m]), "v"(f8scale)); } else { \
            acc[ai][bj][m][n] = __builtin_amdgcn_mfma_f32_16x16x32_bf16(PG8_LO(Bt[n]), PG8_LO(At[m]), acc[ai][bj][m][n], 0, 0, 0); \
            acc[ai][bj][m][n] = __builtin_amdgcn_mfma_f32_16x16x32_bf16(PG8_HI(Bt[n]), PG8_HI(At[m]), acc[ai][bj][m][n], 0, 0, 0); } } \
        __builtin_amdgcn_s_setprio(0); } while (0)
#define PG8_WAIT_V(n) asm volatile("s_waitcnt vmcnt(" #n ")" ::: "memory")
#define PG8_WAIT_L(n) asm volatile("s_waitcnt lgkmcnt(" #n ")" ::: "memory")
#define PG8_BAR __builtin_amdgcn_s_barrier()
#define PG8_SCHED __builtin_amdgcn_sched_barrier(0)
#define P5_KLOOP(NT, cA, cpm, cKB, cB, nA, npm_, nKB, nB) do { _Pragma("unroll 1") for (int t = 0; t < (NT); t += 2) { \
            const bool last = (t == (NT) - 2); \
            const char* a1 = (cA) + (size_t)(t + 1) * 128; \
            const char* a2 = last ? (nA) : (cA) + (size_t)(t + 2) * 128; const char* b2 = last ? (nB) : (cB) + (size_t)(t + 2) * 128; \
            const char* a3 = a2 + 128; const char* b3 = b2 + 128; const size_t hs2 = (size_t)HALF * (last ? (nKB) : (cKB)); \
            const int spm = last ? (npm_) : (cpm), sKB = last ? (nKB) : (cKB); \
            PG8_LDB(B0, 0, 0); PG8_LDB(B1, 0, 1); PG8_SCHED; PG8_LDA(At, 0, 0); PG8_STAGE(PG8_SA(1, 1), a1, P5_AO(cpm, cKB, 1, 0), P5_AO(cpm, cKB, 1, 1)); \
            PG8_WAIT_V(8); PG8_WAIT_L(0); PG8_BAR; PG8_MMA(0, 0, At, B0); PG8_MMA(0, 1, At, B1); PG8_BAR; PG8_SCHED; \
            PG8_LDA(At, 0, 1); PG8_STAGE(PG8_SB(0, 0), b2, P5_BO(sKB, 0), P5_BO(sKB, 1)); PG8_STAGE(PG8_SB(0, 1), b2 + hs2, P5_BO(sKB, 0), P5_BO(sKB, 1)); PG8_STAGE(PG8_SA(0, 0), a2, P5_AO(spm, sKB, 0, 0), P5_AO(spm, sKB, 0, 1)); \
            PG8_WAIT_V(8); PG8_WAIT_L(0); PG8_BAR; PG8_MMA(1, 0, At, B0); PG8_MMA(1, 1, At, B1); PG8_BAR; PG8_SCHED; \
            PG8_LDB(B0, 1, 0); PG8_LDB(B1, 1, 1); PG8_SCHED; PG8_LDA(At, 1, 0); PG8_STAGE(PG8_SA(0, 1), a2, P5_AO(spm, sKB, 1, 0), P5_AO(spm, sKB, 1, 1)); \
            PG8_WAIT_V(8); PG8_WAIT_L(0); PG8_BAR; PG8_MMA(0, 0, At, B0); PG8_MMA(0, 1, At, B1); PG8_BAR; PG8_SCHED; \
            PG8_LDA(At, 1, 1); PG8_STAGE(PG8_SB(1, 0), b3, P5_BO(sKB, 0), P5_BO(sKB, 1)); PG8_STAGE(PG8_SB(1, 1), b3 + hs2, P5_BO(sKB, 0), P5_BO(sKB, 1)); PG8_STAGE(PG8_SA(1, 0), a3, P5_AO(spm, sKB, 0, 0), P5_AO(spm, sKB, 0, 1)); \
            PG8_WAIT_V(8); PG8_WAIT_L(0); PG8_BAR; PG8_MMA(1, 0, At, B0); PG8_MMA(1, 1, At, B1); PG8_BAR; PG8_SCHED; } } while (0)
    int pm, pn, npm, npn, ti = 0;
    if (!tile_order(0, G, c, NTOK / 256, 4, pm, pn)) return;
    f32x4 acc[2][2][4][2];
#pragma unroll
    for (int a = 0; a < 2; ++a)
#pragma unroll
        for (int b = 0; b < 2; ++b)
#pragma unroll
            for (int m = 0; m < 4; ++m)
#pragma unroll
                for (int n = 0; n < 2; ++n) acc[a][b][m][n] = (f32x4){0.f, 0.f, 0.f, 0.f};
    i32x8 At[4], B0[2], B1[2];
    const char* const Y_ = (const char*)Yb; const char* const O_ = (const char*)Ob;
    const char* cB0 = (const char*)Wft + (size_t)pn * 256 * KB0; const char* cB1 = (const char*)Waot + (size_t)pn * 256 * KB1;
    constexpr size_t HS0 = (size_t)HALF * KB0;
    PG8_STAGE(PG8_SB(0, 0), cB0, P5_BO(KB0, 0), P5_BO(KB0, 1)); PG8_STAGE(PG8_SB(0, 1), cB0 + HS0, P5_BO(KB0, 0), P5_BO(KB0, 1)); PG8_STAGE(PG8_SA(0, 0), Y_, P5_AO(pm, KB0, 0, 0), P5_AO(pm, KB0, 0, 1)); PG8_STAGE(PG8_SA(0, 1), Y_, P5_AO(pm, KB0, 1, 0), P5_AO(pm, KB0, 1, 1));
    if (wr == 1) PG8_BAR;
    PG8_WAIT_V(2); PG8_BAR;
    PG8_STAGE(PG8_SB(1, 0), cB0 + 128, P5_BO(KB0, 0), P5_BO(KB0, 1)); PG8_STAGE(PG8_SA(1, 0), Y_ + 128, P5_AO(pm, KB0, 0, 0), P5_AO(pm, KB0, 0, 1)); PG8_STAGE(PG8_SB(1, 1), cB0 + HS0 + 128, P5_BO(KB0, 0), P5_BO(KB0, 1));
    PG8_WAIT_V(6); PG8_BAR;
    for (;;) {
        const bool has_next = tile_order(ti + 1, G, c, NTOK / 256, 4, npm, npn);
        if (!has_next) { npm = pm; npn = pn; }
        const char* nB0 = (const char*)Wft + (size_t)npn * 256 * KB0;
        P5_KLOOP(NT0, Y_, pm, KB0, cB0, O_, pm, KB1, cB1);
        if (wr == 0) PG8_BAR;
        asm volatile("s_nop 15\n\ts_nop 15" ::: "memory");
        {
#pragma unroll
            for (int ai = 0; ai < 2; ++ai) { u32x4 fw[4][2], gw[4][2];
#pragma unroll
                for (int m = 0; m < 4; ++m) { const size_t row = (size_t)(pm * 256 + ai * 128 + wr * 64 + m * 16 + fr);
#pragma unroll
                    for (int bj = 0; bj < 2; ++bj) { const int col = pn * 256 + bj * 128 + wc * 32 + 8 * fq; fw[m][bj] = *(const u32x4*)(Gb + row * 2048 + col); gw[m][bj] = *(const u32x4*)(Gb + row * 2048 + 1024 + col); } }
                PG8_SCHED;
#pragma unroll
                for (int m = 0; m < 4; ++m) {
#pragma unroll
                    for (int bj = 0; bj < 2; ++bj) { f32x4 f0, f1, g0, g1; unpack8(fw[m][bj], f0, f1); unpack8(gw[m][bj], g0, g1);
#pragma unroll
                        for (int j = 0; j < 4; ++j) { const float r0 = (MIX_F8 ? 16.0f : 1.0f) * f0[j] * __builtin_amdgcn_rcpf(g0[j]), r1 = (MIX_F8 ? 16.0f : 1.0f) * f1[j] * __builtin_amdgcn_rcpf(g1[j]);
                            asm volatile("v_mul_f32 %0, %0, %1" : "+v"(acc[ai][bj][m][0][j]) : "v"(r0)); asm volatile("v_mul_f32 %0, %0, %1" : "+v"(acc[ai][bj][m][1][j]) : "v"(r1)); } }
                    PG8_SCHED; } }
        }
        if (wr == 1) PG8_BAR;
        P5_KLOOP(NT1, O_, pm, KB1, cB1, Y_, npm, KB0, nB0);
        if (wr == 0) PG8_BAR;
        {
            int fr2 = fr; asm volatile("" : "+v"(fr2));
#pragma unroll
            for (int ai = 0; ai < 2; ++ai) { u32x4 gw[4][2];
#pragma unroll
                for (int m = 0; m < 4; ++m) { const size_t row = (size_t)(pm * 256 + ai * 128 + wr * 64 + m * 16 + fr2);
#pragma unroll
                    for (int bj = 0; bj < 2; ++bj) gw[m][bj] = *(const u32x4*)(Gb + row * 2048 + 1024 + pn * 256 + bj * 128 + wc * 32 + 8 * fq); }
                PG8_SCHED;
#pragma unroll
                for (int m = 0; m < 4; ++m) { const size_t row = (size_t)(pm * 256 + ai * 128 + wr * 64 + m * 16 + fr2);
#pragma unroll
                    for (int bj = 0; bj < 2; ++bj) { const int col = pn * 256 + bj * 128 + wc * 32 + 8 * fq;
                        f32x4 g0, g1; unpack8(gw[m][bj], g0, g1);
                        if (MIX_F8) { const f32x4 a0 = g0 * acc[ai][bj][m][0] * (1.0f / 256.0f), a1 = g1 * acc[ai][bj][m][1] * (1.0f / 256.0f);
                            *(u32x2*)((unsigned char*)Mb + row * 1024 + col) = (u32x2){pack4_fp8(a0[0], a0[1], a0[2], a0[3]), pack4_fp8(a1[0], a1[1], a1[2], a1[3])}; }
                        else *(u32x4*)(Mb + row * 1024 + col) = pack8(g0 * acc[ai][bj][m][0], g1 * acc[ai][bj][m][1]); } }
                PG8_SCHED; }
        }
        if (!has_next) break;
#pragma unroll
        for (int a = 0; a < 2; ++a)
#pragma unroll
            for (int b = 0; b < 2; ++b)
#pragma unroll
                for (int m = 0; m < 4; ++m)
#pragma unroll
                    for (int n = 0; n < 2; ++n) acc[a][b][m][n] = (f32x4){0.f, 0.f, 0.f, 0.f};
        pm = npm; pn = npn; ++ti; cB0 = nB0; cB1 = (const char*)Waot + (size_t)pn * 256 * KB1;
        if (wr == 1) PG8_BAR;
    }
    PG8_WAIT_V(0);
    PG8_BAR;
#undef PG8_SA
#undef PG8_SB
#undef PG8_STAGE
#undef PG8_LDA
#undef PG8_LDB
#undef PG8_MMA
#undef PG8_LO
#undef PG8_HI
#undef PG8_LD8
#undef PG8_WAIT_V
#undef PG8_WAIT_L
#undef PG8_BAR
#undef PG8_SCHED
#undef P5_KLOOP
#undef P5_AO
#undef P5_BO
}
}

#ifndef ATT_SG
#define ATT_SG 1
#endif
#ifndef ATT_DMA
#define ATT_DMA 1
#endif
#ifndef ATT_QK8
#define ATT_QK8 1
#endif
#ifndef ATT_PV8
#define ATT_PV8 1
#ifndef ATT_QK6
#define ATT_QK6 1
#endif
#ifndef ATT_PV6
#define ATT_PV6 1
#endif
#endif
#ifndef ATT_SCVT
#define ATT_SCVT 1
#endif
#ifndef ATT_PHASED
#define ATT_PHASED 0
#endif
#ifndef ATT_SDEPTH_FIXED
#define ATT_SDEPTH_FIXED 1
#endif
namespace att {
constexpr int DH = 128, NW = 8, QBLK = 32, KVBLK = 64;
constexpr float SCALE = 0.088388347648318440f;
constexpr float THR = 8.f;
constexpr int LDQ = 1024, LDK = 256;
constexpr size_t SHM_V = KVBLK * DH * 2, SHM_K = KVBLK * DH * 2, SHM_ATTN = 2 * SHM_V + 2 * SHM_K + NW * 64 * 4;
#define KSWZ(row, colB) ((row) * 256 + ((colB) ^ (((row) & 7) << 4)))
#define SBAR() __builtin_amdgcn_sched_barrier(0)
__device__ __forceinline__ int crow(int r, int hi) { return (r & 3) + 8 * (r >> 2) + 4 * hi; }
template <bool FIXED>
__device__ __forceinline__ void partialSM(f32x16& p0, f32x16& p1, float& m_reg, float& mn, float& alpha) {
  if constexpr (FIXED) { alpha = 1.f; mn = 0.f; }
  else {
  constexpr float THR2 = THR * 1.4426950408889634f;
  float pmax = p0[0]; for (int r = 1; r < 16; ++r) pmax = fmaxf(pmax, p0[r]); for (int r = 0; r < 16; ++r) pmax = fmaxf(pmax, p1[r]);
  { auto rr = __builtin_amdgcn_permlane32_swap(__float_as_uint(pmax), __float_as_uint(pmax), false, false);
    pmax = fmaxf(__uint_as_float(rr[0]), __uint_as_float(rr[1])); }
  if (__builtin_expect(__all(pmax - m_reg <= THR2), 1)) { mn = m_reg; alpha = 1.f; }
  else { mn = fmaxf(m_reg, pmax); alpha = __builtin_amdgcn_exp2f(m_reg - mn); m_reg = mn; }
  for (int r = 0; r < 16; ++r) p0[r] = p0[r] - mn; for (int r = 0; r < 16; ++r) p1[r] = p1[r] - mn; }
  for (int r = 0; r < 16; ++r) p0[r] = __builtin_amdgcn_exp2f(p0[r]);
}
__device__ __forceinline__ void finishSM(f32x16& p0, f32x16& p1, float alpha, float& l_reg, bf16x8& pa0, bf16x8& pa1, bf16x8& pa2, bf16x8& pa3) {
  for (int r = 0; r < 16; ++r) p1[r] = __builtin_amdgcn_exp2f(p1[r]);
  float ps = 0; for (int r = 0; r < 16; ++r) ps += p0[r]; for (int r = 0; r < 16; ++r) ps += p1[r];
  { auto rr = __builtin_amdgcn_permlane32_swap(__float_as_uint(ps), __float_as_uint(ps), false, false);
    ps = __uint_as_float(rr[0]) + __uint_as_float(rr[1]); }
  l_reg = l_reg * alpha + ps;
#define PK4(P, BASE, OUT) do { unsigned a0 = cvt_pk_bf16(P[BASE + 0], P[BASE + 1]), a1 = cvt_pk_bf16(P[BASE + 2], P[BASE + 3]);   \
    unsigned b0 = cvt_pk_bf16(P[BASE + 4], P[BASE + 5]), b1 = cvt_pk_bf16(P[BASE + 6], P[BASE + 7]);                              \
    auto r0 = __builtin_amdgcn_permlane32_swap(a0, b0, false, false); auto r1 = __builtin_amdgcn_permlane32_swap(a1, b1, false, false); \
    u32x4 w = {r0[0], r1[0], r0[1], r1[1]}; OUT = *reinterpret_cast<bf16x8*>(&w); } while (0)
  PK4(p0, 0, pa0); PK4(p0, 8, pa1); PK4(p1, 0, pa2); PK4(p1, 8, pa3);
#undef PK4
}
__device__ __forceinline__ void qkt(f32x16& p0, f32x16& p1, const bf16_t* Ks, const bf16x8* qr, int r32, int hi) {
  p0 = f32x16{}; p1 = f32x16{};
  for (int d0 = 0; d0 < 8; ++d0) { int cb = (d0 * 16 + hi * 8) * 2;
    bf16x8 b0 = *reinterpret_cast<const bf16x8*>((const char*)Ks + KSWZ(r32, cb));
    bf16x8 b1 = *reinterpret_cast<const bf16x8*>((const char*)Ks + KSWZ(32 + r32, cb));
    p0 = __builtin_amdgcn_mfma_f32_32x32x16_bf16(b0, qr[d0], p0, 0, 0, 0);
    p1 = __builtin_amdgcn_mfma_f32_32x32x16_bf16(b1, qr[d0], p1, 0, 0, 0); }
}
__device__ __forceinline__ int v_st(int k, int c) { const int kk = (k & ~0xC) | ((k & 4) << 1) | ((k & 8) >> 1); return ((kk >> 3) * 4 + (c >> 5)) * 512 + ((kk & 7) * 32 + (c & 31)) * 2; }
__device__ __forceinline__ int v_rd_base(int lane) { return ((lane & 3) << 3) | (((lane >> 2) & 3) << 6) | (((lane >> 4) & 1) << 5) | (((lane >> 5) & 1) << 8); }
constexpr int v_rd_off(int d0, int ks, int half) { return d0 * 512 + ks * 4096 + half * 2048; }
template <int OFF> __device__ __forceinline__ s16x4 tr_read(int vb) {
  s16x4 r; asm volatile("ds_read_b64_tr_b16 %0, %1 offset:%2" : "=&v"(r) : "v"(vb), "i"(OFF) : "memory"); return r;
}
template <int D0> __device__ __forceinline__ void pv_one(f32x16& od, int vb, bf16x8 pa0, bf16x8 pa1, bf16x8 pa2, bf16x8 pa3) {
  const s16x4 l0 = tr_read<v_rd_off(D0, 0, 0)>(vb), h0 = tr_read<v_rd_off(D0, 0, 1)>(vb), l1 = tr_read<v_rd_off(D0, 1, 0)>(vb), h1 = tr_read<v_rd_off(D0, 1, 1)>(vb);
  const s16x4 l2 = tr_read<v_rd_off(D0, 2, 0)>(vb), h2 = tr_read<v_rd_off(D0, 2, 1)>(vb), l3 = tr_read<v_rd_off(D0, 3, 0)>(vb), h3 = tr_read<v_rd_off(D0, 3, 1)>(vb);
  asm volatile("s_waitcnt lgkmcnt(0)" ::: "memory"); SBAR();
#define PK(L, H) (bf16x8){L[0], L[1], L[2], L[3], H[0], H[1], H[2], H[3]}
  od = __builtin_amdgcn_mfma_f32_32x32x16_bf16(pa0, PK(l0, h0), od, 0, 0, 0);
  od = __builtin_amdgcn_mfma_f32_32x32x16_bf16(pa1, PK(l1, h1), od, 0, 0, 0);
  od = __builtin_amdgcn_mfma_f32_32x32x16_bf16(pa2, PK(l2, h2), od, 0, 0, 0);
  od = __builtin_amdgcn_mfma_f32_32x32x16_bf16(pa3, PK(l3, h3), od, 0, 0, 0);
#undef PK
}
__device__ __forceinline__ void pv_d0(f32x16* o, int vb, bf16x8 pa0, bf16x8 pa1, bf16x8 pa2, bf16x8 pa3) {
  pv_one<0>(o[0], vb, pa0, pa1, pa2, pa3); pv_one<1>(o[1], vb, pa0, pa1, pa2, pa3); pv_one<2>(o[2], vb, pa0, pa1, pa2, pa3); pv_one<3>(o[3], vb, pa0, pa1, pa2, pa3);
}
__device__ __forceinline__ void pv_d0_exp(f32x16* o, int vb, bf16x8 pa0, bf16x8 pa1, bf16x8 pa2, bf16x8 pa3, f32x16& pn) {
  pv_one<0>(o[0], vb, pa0, pa1, pa2, pa3); for (int r = 0; r < 4; ++r) pn[r] = __builtin_amdgcn_exp2f(pn[r]);
  pv_one<1>(o[1], vb, pa0, pa1, pa2, pa3); for (int r = 4; r < 8; ++r) pn[r] = __builtin_amdgcn_exp2f(pn[r]);
  pv_one<2>(o[2], vb, pa0, pa1, pa2, pa3); for (int r = 8; r < 12; ++r) pn[r] = __builtin_amdgcn_exp2f(pn[r]);
  pv_one<3>(o[3], vb, pa0, pa1, pa2, pa3); for (int r = 12; r < 16; ++r) pn[r] = __builtin_amdgcn_exp2f(pn[r]);
  SBAR();
}

#define TR8(S, D0, vb) const s16x4 S##l0 = tr_read<v_rd_off(D0, 0, 0)>(vb), S##h0 = tr_read<v_rd_off(D0, 0, 1)>(vb), S##l1 = tr_read<v_rd_off(D0, 1, 0)>(vb), S##h1 = tr_read<v_rd_off(D0, 1, 1)>(vb), \
    S##l2 = tr_read<v_rd_off(D0, 2, 0)>(vb), S##h2 = tr_read<v_rd_off(D0, 2, 1)>(vb), S##l3 = tr_read<v_rd_off(D0, 3, 0)>(vb), S##h3 = tr_read<v_rd_off(D0, 3, 1)>(vb)
#define TRW(N, S) asm volatile("s_waitcnt lgkmcnt(" #N ")" : "+v"(S##l0), "+v"(S##h0), "+v"(S##l1), "+v"(S##h1), "+v"(S##l2), "+v"(S##h2), "+v"(S##l3), "+v"(S##h3) :: "memory")
#define PVM(od, S) do { od = __builtin_amdgcn_mfma_f32_32x32x16_bf16(pa0, PKV(S##l0, S##h0), od, 0, 0, 0); od = __builtin_amdgcn_mfma_f32_32x32x16_bf16(pa1, PKV(S##l1, S##h1), od, 0, 0, 0); \
    od = __builtin_amdgcn_mfma_f32_32x32x16_bf16(pa2, PKV(S##l2, S##h2), od, 0, 0, 0); od = __builtin_amdgcn_mfma_f32_32x32x16_bf16(pa3, PKV(S##l3, S##h3), od, 0, 0, 0); } while (0)
#define PKV(L, H) (bf16x8){L[0], L[1], L[2], L[3], H[0], H[1], H[2], H[3]}
__device__ __forceinline__ void pv_d0_exp2(f32x16* o, int vb, bf16x8 pa0, bf16x8 pa1, bf16x8 pa2, bf16x8 pa3, f32x16& pn) {
  s16x4 Al0, Ah0, Al1, Ah1, Al2, Ah2, Al3, Ah3, Bl0, Bh0, Bl1, Bh1, Bl2, Bh2, Bl3, Bh3;
#define TRS(S, D0) do { S##l0 = tr_read<v_rd_off(D0, 0, 0)>(vb); S##h0 = tr_read<v_rd_off(D0, 0, 1)>(vb); S##l1 = tr_read<v_rd_off(D0, 1, 0)>(vb); S##h1 = tr_read<v_rd_off(D0, 1, 1)>(vb); \
    S##l2 = tr_read<v_rd_off(D0, 2, 0)>(vb); S##h2 = tr_read<v_rd_off(D0, 2, 1)>(vb); S##l3 = tr_read<v_rd_off(D0, 3, 0)>(vb); S##h3 = tr_read<v_rd_off(D0, 3, 1)>(vb); } while (0)
  TRS(A, 0); TRS(B, 1);
  TRW(8, A); SBAR(); PVM(o[0], A); for (int r = 0; r < 4; ++r) pn[r] = __builtin_amdgcn_exp2f(pn[r]); SBAR();
  TRS(A, 2);
  TRW(8, B); SBAR(); PVM(o[1], B); for (int r = 4; r < 8; ++r) pn[r] = __builtin_amdgcn_exp2f(pn[r]); SBAR();
  TRS(B, 3);
  TRW(8, A); SBAR(); PVM(o[2], A); for (int r = 8; r < 12; ++r) pn[r] = __builtin_amdgcn_exp2f(pn[r]); SBAR();
  TRW(0, B); SBAR(); PVM(o[3], B); for (int r = 12; r < 16; ++r) pn[r] = __builtin_amdgcn_exp2f(pn[r]);
  SBAR();
#undef TRS
}
#undef TR8
#define ATT_SG1() do { if (ATT_SG) { __builtin_amdgcn_sched_group_barrier(0x100, 4, 0); \
    _Pragma("unroll") for (int i_ = 0; i_ < 8; ++i_) { __builtin_amdgcn_sched_group_barrier(0x008, 2, 0); __builtin_amdgcn_sched_group_barrier(0x100, 2, 0); __builtin_amdgcn_sched_group_barrier(0x002, 10, 0); } } } while (0)
template <bool F8Q>
__device__ __forceinline__ void q_norm_rope(bf16x8 (&qr)[8], i32x8 (&qf)[2], const float* __restrict__ qg, const float* __restrict__ ropeR, const float* __restrict__ ropeC, int t0, int wid, int r32, int hi) {
  {
    float sq = 0.f;
#pragma unroll
    for (int d0 = 0; d0 < 8; ++d0) { const u32x4 w = __builtin_bit_cast(u32x4, qr[d0]);
#pragma unroll
      for (int c = 0; c < 4; ++c) { const float a = bf_lo(w[c]), b = bf_hi(w[c]); sq += a * a + b * b; } }
    { auto rr = __builtin_amdgcn_permlane32_swap(__float_as_uint(sq), __float_as_uint(sq), false, false); sq = __uint_as_float(rr[0]) + __uint_as_float(rr[1]); }
    const float rstd = (F8Q ? 8.0f : 1.0f) * (SCALE * 1.4426950408889634f) / sqrtf(sq * (1.0f / 128.0f) + 1e-6f);
    const int t = t0 + wid * QBLK + r32, prow = t >> 6, pcol = t & 63;
#pragma unroll
    for (int pr = 0; pr < 4; ++pr) {
      const int d0a = (pr & 1) + 4 * (pr >> 1), d0b = d0a + 2, fi0 = (pr & 1) * 16 + hi * 8;
      const float* tab = (pr < 2 ? ropeR + (prow * 32 + fi0) * 2 : ropeC + (pcol * 32 + fi0) * 2);
      const u32x4 wa = __builtin_bit_cast(u32x4, qr[d0a]), wb = __builtin_bit_cast(u32x4, qr[d0b]);
      const float* ga = qg + d0a * 16 + hi * 8; const float* gb = qg + d0b * 16 + hi * 8;
      float oa[8], ob[8];
#pragma unroll
      for (int j = 0; j < 8; ++j) {
        const float xa = (j & 1) ? bf_hi(wa[j >> 1]) : bf_lo(wa[j >> 1]), xb = (j & 1) ? bf_hi(wb[j >> 1]) : bf_lo(wb[j >> 1]);
        const float y1 = xa * rstd * ga[j], y2 = xb * rstd * gb[j], cs = tab[2 * j], sn = tab[2 * j + 1];
        oa[j] = y1 * cs - y2 * sn; ob[j] = y2 * cs + y1 * sn; }
      u32x4 pa, pb;
#pragma unroll
      for (int c = 0; c < 4; ++c) { pa[c] = cvt_pk_bf16(oa[2 * c], oa[2 * c + 1]); pb[c] = cvt_pk_bf16(ob[2 * c], ob[2 * c + 1]); }
      if constexpr (F8Q) {
        qf[d0a >> 2][2 * (d0a & 3)] = (int)pack4_fp8(oa[0], oa[1], oa[2], oa[3]); qf[d0a >> 2][2 * (d0a & 3) + 1] = (int)pack4_fp8(oa[4], oa[5], oa[6], oa[7]);
        qf[d0b >> 2][2 * (d0b & 3)] = (int)pack4_fp8(ob[0], ob[1], ob[2], ob[3]); qf[d0b >> 2][2 * (d0b & 3) + 1] = (int)pack4_fp8(ob[4], ob[5], ob[6], ob[7]);
      } else { qr[d0a] = __builtin_bit_cast(bf16x8, pa); qr[d0b] = __builtin_bit_cast(bf16x8, pb); }
    }
  }
}
template <bool FIXED>
__device__ __forceinline__ void attn_dense_body(const bf16_t* Qb, const bf16_t* __restrict__ Kh, const bf16_t* __restrict__ Vh, bf16_t* Ob, int seq, char* lds,
                                                const float* __restrict__ qg, const float* __restrict__ ropeR, const float* __restrict__ ropeC, int t0) {
  const int tid = tid_fresh(), wid = tid >> 6, lane = tid & 63, r32 = lane & 31, hi = lane >> 5;
  bf16_t* V_lds = (bf16_t*)lds; bf16_t* K_lds = (bf16_t*)(lds + 2 * SHM_V);
  float* ws = (float*)(lds + 2 * SHM_V + 2 * SHM_K) + wid * 64; float* li_l = ws; float* al_l = ws + 32;
  float m_reg = -1e30f, l_reg = 0; bf16x8 qr[8];
  const bf16_t* Qw = Qb + (long)(wid * QBLK + r32) * LDQ + hi * 8;
#pragma unroll
  for (int d0 = 0; d0 < 8; ++d0) qr[d0] = *reinterpret_cast<const bf16x8*>(Qw + d0 * 16);
  { i32x8 qf_[2]; q_norm_rope<false>(qr, qf_, qg, ropeR, ropeC, t0, wid, r32, hi); }
  f32x16 o[4] = {};
  const int sr = tid >> 4, sc = (tid & 15) * 8, vst0 = v_st(sr, sc), vst1 = v_st(32 + sr, sc);
  const int vb0 = (int)(uintptr_t)V_lds + v_rd_base(lane);
  constexpr int SDP = FIXED ? ATT_SDEPTH_FIXED : 1;
  struct { bf16x8 vs0, vs1, ks0, ks1; } sr_[SDP];
#define LD8(p) (*reinterpret_cast<const bf16x8*>(p))
#define SLOAD(i, k0) do { sr_[i].vs0 = LD8(&Vh[(long)((k0) + sr) * LDK + sc]); sr_[i].vs1 = LD8(&Vh[(long)((k0) + 32 + sr) * LDK + sc]); \
    sr_[i].ks0 = LD8(&Kh[(long)((k0) + sr) * LDK + sc]); sr_[i].ks1 = LD8(&Kh[(long)((k0) + 32 + sr) * LDK + sc]); } while (0)
#define SWRITE(b, i) do { *(bf16x8*)((char*)V_lds + (b) * SHM_V + vst0) = sr_[i].vs0;          \
    *(bf16x8*)((char*)V_lds + (b) * SHM_V + vst1) = sr_[i].vs1; int kc = sc * 2;               \
    *(bf16x8*)((char*)K_lds + (b) * SHM_K + KSWZ(sr, kc)) = sr_[i].ks0;                       \
    *(bf16x8*)((char*)K_lds + (b) * SHM_K + KSWZ(32 + sr, kc)) = sr_[i].ks1; } while (0)
#define SWAIT() do { if (SDP == 2) asm volatile("s_waitcnt vmcnt(4)" ::: "memory"); else asm volatile("s_waitcnt vmcnt(0)" ::: "memory"); } while (0)
#define RESC(a) do { if (!FIXED && __any((a) < 1.f)) { if (hi == 0) al_l[r32] = (a); asm volatile("s_waitcnt lgkmcnt(0)" ::: "memory"); \
    for (int d = 0; d < 4; ++d) for (int r = 0; r < 16; ++r) o[d][r] *= al_l[crow(r, hi)]; } } while (0)
  f32x16 pA0, pA1, pB0, pB1; float mnA, mnB, alA, alB; bf16x8 pa0, pa1, pa2, pa3; const int NT = seq / KVBLK;
  constexpr int SE = 0, SO = SDP - 1;
  SLOAD(SE, 0); asm volatile("s_waitcnt vmcnt(0)" ::: "memory"); SWRITE(0, SE); __syncthreads();
  qkt(pA0, pA1, K_lds, qr, r32, hi); partialSM<FIXED>(pA0, pA1, m_reg, mnA, alA);
  SLOAD(SO, KVBLK); if (SDP == 2) { if (2 < NT) SLOAD(SE, 2 * KVBLK); }
  SWAIT(); SWRITE(1, SO); __syncthreads();
  for (int j = 1; j + 1 < NT; j += 2) {
    SBAR(); qkt(pB0, pB1, (bf16_t*)((char*)K_lds + SHM_K), qr, r32, hi);
    finishSM(pA0, pA1, alA, l_reg, pa0, pa1, pa2, pa3); ATT_SG1(); SBAR();
    SLOAD(SO, (j + SDP) * KVBLK); SBAR();
    if constexpr (FIXED) { pv_d0_exp(o, vb0, pa0, pa1, pa2, pa3, pB0); alB = 1.f; } else { pv_d0(o, vb0, pa0, pa1, pa2, pa3); partialSM<FIXED>(pB0, pB1, m_reg, mnB, alB); SBAR(); }
    __syncthreads(); SWAIT(); SWRITE(0, SE);
    RESC(alB); __syncthreads();
    SBAR(); qkt(pA0, pA1, K_lds, qr, r32, hi);
    finishSM(pB0, pB1, alB, l_reg, pa0, pa1, pa2, pa3); ATT_SG1(); SBAR();
    if (SDP == 1 || j + 3 < NT) SLOAD(SE, (j + 1 + SDP) * KVBLK); SBAR();
    if constexpr (FIXED) { pv_d0_exp(o, vb0 + (int)SHM_V, pa0, pa1, pa2, pa3, pA0); alA = 1.f; } else { pv_d0(o, vb0 + (int)SHM_V, pa0, pa1, pa2, pa3); partialSM<FIXED>(pA0, pA1, m_reg, mnA, alA); SBAR(); }
    __syncthreads(); SWAIT(); SWRITE(1, SO);
    RESC(alA); __syncthreads();
  }
  SBAR(); qkt(pB0, pB1, (bf16_t*)((char*)K_lds + SHM_K), qr, r32, hi);
  finishSM(pA0, pA1, alA, l_reg, pa0, pa1, pa2, pa3); SBAR();
  if constexpr (FIXED) { pv_d0_exp(o, vb0, pa0, pa1, pa2, pa3, pB0); alB = 1.f; } else { pv_d0(o, vb0, pa0, pa1, pa2, pa3); partialSM<FIXED>(pB0, pB1, m_reg, mnB, alB); SBAR(); }
  __syncthreads(); RESC(alB);
  finishSM(pB0, pB1, alB, l_reg, pa0, pa1, pa2, pa3); SBAR();
  pv_d0(o, vb0 + (int)SHM_V, pa0, pa1, pa2, pa3);
  if (hi == 0) li_l[r32] = l_reg; asm volatile("s_waitcnt lgkmcnt(0)" ::: "memory");
  float rli[16];
#pragma unroll
  for (int r = 0; r < 16; ++r) rli[r] = __builtin_amdgcn_rcpf(li_l[crow(r, hi)]);
  bf16_t* Ow = Ob + (long)(wid * QBLK) * LDQ;
#pragma unroll
  for (int r = 0; r < 16; ++r) { int orow = crow(r, hi);
    for (int d0 = 0; d0 < 4; ++d0) Ow[(long)orow * LDQ + d0 * 32 + r32] = (bf16_t)(cvt_pk_bf16(o[d0][r] * rli[r], 0.f) & 0xffffu); }
  __syncthreads();
#undef LD8
#undef SLOAD
#undef SWRITE
#undef SWAIT
#undef RESC
}

__device__ __forceinline__ void q_norm_rope6(const bf16x8 (&qr)[8], i32x8 (&qf)[2], int (&qsc)[2], const float* __restrict__ qg, const float* __restrict__ ropeR, const float* __restrict__ ropeC, int t0, int wid, int r32, int hi) {
  float sq = 0.f;
#pragma unroll
  for (int d0 = 0; d0 < 8; ++d0) { const u32x4 w = __builtin_bit_cast(u32x4, qr[d0]);
#pragma unroll
    for (int c = 0; c < 4; ++c) { const float a = bf_lo(w[c]), b = bf_hi(w[c]); sq += a * a + b * b; } }
  { auto rr = __builtin_amdgcn_permlane32_swap(__float_as_uint(sq), __float_as_uint(sq), false, false); sq = __uint_as_float(rr[0]) + __uint_as_float(rr[1]); }
  const float rstd = (SCALE * 1.4426950408889634f) / sqrtf(sq * (1.0f / 128.0f) + 1e-6f);
  const int t = t0 + wid * QBLK + r32, prow = t >> 6, pcol = t & 63;
#pragma unroll
  for (int s = 0; s < 2; ++s) { f32x16 A, B; float mx = 0.f;
#pragma unroll
    for (int h2 = 0; h2 < 2; ++h2) { const int pr = 2 * s + h2, d0a = (pr & 1) + 4 * (pr >> 1), d0b = d0a + 2, fi0 = (pr & 1) * 16 + hi * 8;
      const float* tab = (pr < 2 ? ropeR + (prow * 32 + fi0) * 2 : ropeC + (pcol * 32 + fi0) * 2);
      const u32x4 wa = __builtin_bit_cast(u32x4, qr[d0a]), wb = __builtin_bit_cast(u32x4, qr[d0b]);
      const float* ga = qg + d0a * 16 + hi * 8; const float* gb = qg + d0b * 16 + hi * 8;
#pragma unroll
      for (int j = 0; j < 8; ++j) {
        const float xa = (j & 1) ? bf_hi(wa[j >> 1]) : bf_lo(wa[j >> 1]), xb = (j & 1) ? bf_hi(wb[j >> 1]) : bf_lo(wb[j >> 1]);
        const float y1 = xa * rstd * ga[j], y2 = xb * rstd * gb[j], cs = tab[2 * j], sn = tab[2 * j + 1];
        const float va = y1 * cs - y2 * sn, vb = y2 * cs + y1 * sn;
        A[8 * h2 + j] = va; B[8 * h2 + j] = vb; mx = fmaxf(mx, fmaxf(fabsf(va), fabsf(vb))); } }
    unsigned e8 = (__float_as_uint(mx) >> 23) & 0xffu; e8 = (e8 < 8u ? 8u : e8) - 2u;
    const u32x6 p6 = __builtin_amdgcn_cvt_scalef32_2xpk16_fp6_f32(A, B, __uint_as_float(e8 << 23));
    qf[s] = (i32x8){(int)p6[0], (int)p6[1], (int)p6[2], (int)p6[3], (int)p6[4], (int)p6[5], 0, 0}; qsc[s] = (int)(e8 * 0x01010101u); }
}
__device__ __forceinline__ void qkt_f6(f32x16& p0, f32x16& p1, const char* Ks, const i32x8 (&qf)[2], const int (&qsc)[2], int r32, int hi) {
  p0 = f32x16{}; p1 = f32x16{};
#pragma unroll
  for (int s = 0; s < 2; ++s) {
    const int k0 = r32, k1 = 32 + r32, c0 = 4 * s + 2 * hi;
    const i32x4 a00 = *(const i32x4*)(Ks + k0 * 128 + (((c0) ^ ((k0 >> 1) & 7)) << 4)), a01 = *(const i32x4*)(Ks + k0 * 128 + (((c0 + 1) ^ ((k0 >> 1) & 7)) << 4));
    const i32x4 a10 = *(const i32x4*)(Ks + k1 * 128 + (((c0) ^ ((k1 >> 1) & 7)) << 4)), a11 = *(const i32x4*)(Ks + k1 * 128 + (((c0 + 1) ^ ((k1 >> 1) & 7)) << 4));
    p0 = __builtin_amdgcn_mfma_scale_f32_32x32x64_f8f6f4(__builtin_shufflevector(a00, a01, 0, 1, 2, 3, 4, 5, 6, 7), qf[s], p0, 2, 2, 0, a01[2], 0, qsc[s]);
    p1 = __builtin_amdgcn_mfma_scale_f32_32x32x64_f8f6f4(__builtin_shufflevector(a10, a11, 0, 1, 2, 3, 4, 5, 6, 7), qf[s], p1, 2, 2, 0, a11[2], 0, qsc[s]);
  }
}
__device__ __forceinline__ void qkt_f8(f32x16& p0, f32x16& p1, const char* Ks, const i32x8 (&qf)[2], int r32, int hi) {
  p0 = f32x16{}; p1 = f32x16{};
#pragma unroll
  for (int s = 0; s < 2; ++s) {
    const int k0 = r32, k1 = 32 + r32, c0 = 4 * s + 2 * hi;
    const i32x4 a00 = *(const i32x4*)(Ks + k0 * 128 + (((c0) ^ ((k0 >> 1) & 7)) << 4)), a01 = *(const i32x4*)(Ks + k0 * 128 + (((c0 + 1) ^ ((k0 >> 1) & 7)) << 4));
    const i32x4 a10 = *(const i32x4*)(Ks + k1 * 128 + (((c0) ^ ((k1 >> 1) & 7)) << 4)), a11 = *(const i32x4*)(Ks + k1 * 128 + (((c0 + 1) ^ ((k1 >> 1) & 7)) << 4));
    p0 = __builtin_amdgcn_mfma_scale_f32_32x32x64_f8f6f4(__builtin_shufflevector(a00, a01, 0, 1, 2, 3, 4, 5, 6, 7), qf[s], p0, 0, 0, 0, 0x7f7f7f7f, 0, 0x7c7c7c7c);
    p1 = __builtin_amdgcn_mfma_scale_f32_32x32x64_f8f6f4(__builtin_shufflevector(a10, a11, 0, 1, 2, 3, 4, 5, 6, 7), qf[s], p1, 0, 0, 0, 0x7f7f7f7f, 0, 0x7c7c7c7c);
  }
}
#define ATT_SG8() do { if (ATT_SG) { __builtin_amdgcn_sched_group_barrier(0x100, 8, 0); \
    _Pragma("unroll") for (int i_ = 0; i_ < 4; ++i_) { __builtin_amdgcn_sched_group_barrier(0x008, 1, 0); __builtin_amdgcn_sched_group_barrier(0x002, 20, 0); } } } while (0)
template <bool QK8>
__device__ __forceinline__ void attn_dma_body(const bf16_t* Qb, const bf16_t* __restrict__ Kh, const unsigned char* __restrict__ Kf8h, const bf16_t* __restrict__ Vh, bf16_t* Ob, int seq, char* lds,
                                              const float* __restrict__ qg, const float* __restrict__ ropeR, const float* __restrict__ ropeC, int t0) {
  const int tid = tid_fresh(), wid = __builtin_amdgcn_readfirstlane(tid >> 6), lane = tid & 63, r32 = lane & 31, hi = lane >> 5;
  constexpr int SLOT = 16384, KSL = QK8 ? 8192 : 16384, VOFF = 3 * KSL;
  char* K_l = lds; float* ws = (float*)(lds + VOFF + 3 * SLOT) + wid * 64; float* li_l = ws;
  const unsigned ldsb = (unsigned)(uintptr_t)lds;
  float l_reg = 0; bf16x8 qr[8];
  const bf16_t* Qw = Qb + (long)(wid * QBLK + r32) * LDQ + hi * 8;
#pragma unroll
  for (int d0 = 0; d0 < 8; ++d0) qr[d0] = *reinterpret_cast<const bf16x8*>(Qw + d0 * 16);
  i32x8 qf[2];
  q_norm_rope<QK8>(qr, qf, qg, ropeR, ropeC, t0, wid, r32, hi);
  f32x16 o[4] = {};
  int koff[2], voff[2];
#pragma unroll
  for (int i = 0; i < 2; ++i) { const int P = wid * 128 + i * 64 + lane;
    if constexpr (QK8) { const int P8 = wid * 64 + lane, key = P8 >> 3, c = (P8 & 7) ^ ((key >> 1) & 7); koff[i] = key * 256 + c * 16; }
    else { const int row = P >> 4, c = (P & 15) ^ (row & 7); koff[i] = row * LDK + c * 8; }
    { const int st = P >> 5, rowk = (P & 31) >> 2, cch = P & 3, kk = (st >> 2) * 8 + rowk, k = (kk & ~0xC) | ((kk & 4) << 1) | ((kk & 8) >> 1); voff[i] = k * LDK + (st & 3) * 32 + cch * 8; } }
  const int vb0 = (int)ldsb + VOFF + v_rd_base(lane);
#define DMA_K(slot, tile) do { if constexpr (QK8) { const unsigned char* g8_ = Kf8h + (long)(tile) * (KVBLK * 256); \
        __builtin_amdgcn_global_load_lds((const unsigned*)(g8_ + koff[0]), (LAS unsigned*)(ldsb + (slot) * KSL + wid * 1024), 16, 0, 0); } else { \
    const bf16_t* g_ = Kh + (long)(tile) * (KVBLK * LDK); \
    __builtin_amdgcn_global_load_lds((const unsigned*)(g_ + koff[0]), (LAS unsigned*)(ldsb + (slot) * SLOT + wid * 2048), 16, 0, 0); \
    __builtin_amdgcn_global_load_lds((const unsigned*)(g_ + koff[1]), (LAS unsigned*)(ldsb + (slot) * SLOT + wid * 2048 + 1024), 16, 0, 0); } } while (0)
#define DMA_V(slot, tile) do { const bf16_t* g_ = Vh + (long)(tile) * (KVBLK * LDK); \
    __builtin_amdgcn_global_load_lds((const unsigned*)(g_ + voff[0]), (LAS unsigned*)(ldsb + VOFF + (slot) * SLOT + wid * 2048), 16, 0, 0); \
    __builtin_amdgcn_global_load_lds((const unsigned*)(g_ + voff[1]), (LAS unsigned*)(ldsb + VOFF + (slot) * SLOT + wid * 2048 + 1024), 16, 0, 0); } while (0)
#define KSLOT(s_) ((const bf16_t*)(K_l + (s_) * KSL))
#define QKT(P0, P1, s_) do { if constexpr (QK8) qkt_f8(P0, P1, (const char*)KSLOT(s_), qf, r32, hi); else qkt(P0, P1, KSLOT(s_), qr, r32, hi); } while (0)
  f32x16 pA0, pA1, pB0, pB1; bf16x8 pa0, pa1, pa2, pa3; const int NT = seq / KVBLK;
  DMA_K(0, 0); DMA_V(0, 0); DMA_K(1, 1);
  asm volatile("s_waitcnt vmcnt(0)" ::: "memory"); __builtin_amdgcn_s_barrier(); SBAR();
  QKT(pA0, pA1, 0);
  for (int r = 0; r < 16; ++r) pA0[r] = __builtin_amdgcn_exp2f(pA0[r]);
  DMA_K(2, 2); DMA_V(1, 1);
  __builtin_amdgcn_s_barrier(); SBAR();
#define HALF(PN0, PN1, PO0, PO1, t_, KS, VS, KD, VD) do { const int tk_ = (t_) + 2 < NT ? (t_) + 2 : NT - 1, tv_ = (t_) + 1 < NT ? (t_) + 1 : NT - 1; \
    DMA_K(KD, tk_); DMA_V(VD, tv_); \
    SBAR(); QKT(PN0, PN1, KS); finishSM(PO0, PO1, 1.f, l_reg, pa0, pa1, pa2, pa3); if constexpr (QK8) { ATT_SG8(); } else { ATT_SG1(); } SBAR(); \
    pv_d0_exp2(o, vb0 + (VS) * SLOT, pa0, pa1, pa2, pa3, PN0); \
    if constexpr (QK8) asm volatile("s_waitcnt vmcnt(3)" ::: "memory"); else asm volatile("s_waitcnt vmcnt(4)" ::: "memory"); __builtin_amdgcn_s_barrier(); SBAR(); } while (0)
  int t = 1;
  for (; t + 5 < NT; t += 6) {
    HALF(pB0, pB1, pA0, pA1, t,     1, 0, 0, 2);
    HALF(pA0, pA1, pB0, pB1, t + 1, 2, 1, 1, 0);
    HALF(pB0, pB1, pA0, pA1, t + 2, 0, 2, 2, 1);
    HALF(pA0, pA1, pB0, pB1, t + 3, 1, 0, 0, 2);
    HALF(pB0, pB1, pA0, pA1, t + 4, 2, 1, 1, 0);
    HALF(pA0, pA1, pB0, pB1, t + 5, 0, 2, 2, 1);
  }
  HALF(pB0, pB1, pA0, pA1, t, 1, 0, 0, 2);
  finishSM(pB0, pB1, 1.f, l_reg, pa0, pa1, pa2, pa3); SBAR();
  pv_d0(o, vb0 + 1 * SLOT, pa0, pa1, pa2, pa3);
  if (hi == 0) li_l[r32] = l_reg; asm volatile("s_waitcnt lgkmcnt(0)" ::: "memory");
  float rli[16];
#pragma unroll
  for (int r = 0; r < 16; ++r) rli[r] = __builtin_amdgcn_rcpf(li_l[crow(r, hi)]);
  bf16_t* Ow = Ob + (long)(wid * QBLK) * LDQ;
#pragma unroll
  for (int r = 0; r < 16; ++r) { int orow = crow(r, hi);
    for (int d0 = 0; d0 < 4; ++d0) Ow[(long)orow * LDQ + d0 * 32 + r32] = (bf16_t)(cvt_pk_bf16(o[d0][r] * rli[r], 0.f) & 0xffffu); }
  asm volatile("s_waitcnt vmcnt(0) lgkmcnt(0)" ::: "memory"); __builtin_amdgcn_s_barrier(); SBAR();
#undef DMA_K
#undef DMA_V
#undef KSLOT
#undef QKT
#undef HALF
}

__device__ __forceinline__ void finishSM_f8(f32x16& p0, f32x16& p1, i32x8& pf, int& psc) {
  for (int r = 0; r < 16; ++r) p1[r] = __builtin_amdgcn_exp2f(p1[r]);
  float pm = 0; for (int r = 0; r < 16; ++r) pm = fmaxf(pm, p0[r]); for (int r = 0; r < 16; ++r) pm = fmaxf(pm, p1[r]);
  const unsigned e8 = (__float_as_uint(pm) >> 23) & 0xffu;
  const float mul = __uint_as_float((261u - e8) << 23);
  psc = (int)((e8 - 7u) * 0x01010101u);
#if ATT_SCVT
  typedef short v2s_t __attribute__((ext_vector_type(2)));
  const float qs = (ATT_SCVT == 1) ? __uint_as_float((e8 - 7u) << 23) : mul;
#pragma unroll
  for (int c = 0; c < 4; ++c) { v2s_t w = {0, 0};
    w = __builtin_amdgcn_cvt_scalef32_pk_fp8_f32(w, p0[4 * c], p0[4 * c + 1], qs, false); w = __builtin_amdgcn_cvt_scalef32_pk_fp8_f32(w, p0[4 * c + 2], p0[4 * c + 3], qs, true); pf[c] = __builtin_bit_cast(int, w);
    v2s_t u = {0, 0};
    u = __builtin_amdgcn_cvt_scalef32_pk_fp8_f32(u, p1[4 * c], p1[4 * c + 1], qs, false); u = __builtin_amdgcn_cvt_scalef32_pk_fp8_f32(u, p1[4 * c + 2], p1[4 * c + 3], qs, true); pf[4 + c] = __builtin_bit_cast(int, u); }
#else
#pragma unroll
  for (int c = 0; c < 4; ++c) { pf[c] = (int)pack4_fp8_nc(p0[4 * c] * mul, p0[4 * c + 1] * mul, p0[4 * c + 2] * mul, p0[4 * c + 3] * mul);
                                pf[4 + c] = (int)pack4_fp8_nc(p1[4 * c] * mul, p1[4 * c + 1] * mul, p1[4 * c + 2] * mul, p1[4 * c + 3] * mul); }
#endif
}
__device__ __forceinline__ void finishSM_f8_tail(f32x16& p0, f32x16& p1, i32x8& pf, int& psc) {
  float pm = 0; for (int r = 0; r < 16; ++r) pm = fmaxf(pm, p0[r]); for (int r = 0; r < 16; ++r) pm = fmaxf(pm, p1[r]);
  const unsigned e8 = (__float_as_uint(pm) >> 23) & 0xffu;
  const float mul = __uint_as_float((261u - e8) << 23);
  psc = (int)((e8 - 7u) * 0x01010101u);
#if ATT_SCVT
  typedef short v2s_t __attribute__((ext_vector_type(2)));
  const float qs = (ATT_SCVT == 1) ? __uint_as_float((e8 - 7u) << 23) : mul;
#pragma unroll
  for (int c = 0; c < 4; ++c) { v2s_t w = {0, 0};
    w = __builtin_amdgcn_cvt_scalef32_pk_fp8_f32(w, p0[4 * c], p0[4 * c + 1], qs, false); w = __builtin_amdgcn_cvt_scalef32_pk_fp8_f32(w, p0[4 * c + 2], p0[4 * c + 3], qs, true); pf[c] = __builtin_bit_cast(int, w);
    v2s_t u = {0, 0};
    u = __builtin_amdgcn_cvt_scalef32_pk_fp8_f32(u, p1[4 * c], p1[4 * c + 1], qs, false); u = __builtin_amdgcn_cvt_scalef32_pk_fp8_f32(u, p1[4 * c + 2], p1[4 * c + 3], qs, true); pf[4 + c] = __builtin_bit_cast(int, u); }
#else
#pragma unroll
  for (int c = 0; c < 4; ++c) { pf[c] = (int)pack4_fp8_nc(p0[4 * c] * mul, p0[4 * c + 1] * mul, p0[4 * c + 2] * mul, p0[4 * c + 3] * mul);
                                pf[4 + c] = (int)pack4_fp8_nc(p1[4 * c] * mul, p1[4 * c + 1] * mul, p1[4 * c + 2] * mul, p1[4 * c + 3] * mul); }
#endif
}
__device__ __forceinline__ void o_bf16_to_fp8(const bf16_t* Qp, unsigned char* O8p) {
  __syncthreads();
  const int tid = tid_fresh(), row = tid >> 1, c0 = (tid & 1) * 64;
#pragma unroll
  for (int q = 0; q < 4; ++q) { const u32x4 w0 = *(const u32x4*)(Qp + (size_t)row * 1024 + c0 + 16 * q), w1 = *(const u32x4*)(Qp + (size_t)row * 1024 + c0 + 16 * q + 8);
    u32x4 o; o.x = pack4_fp8(bf_lo(w0.x) * 8.f, bf_hi(w0.x) * 8.f, bf_lo(w0.y) * 8.f, bf_hi(w0.y) * 8.f); o.y = pack4_fp8(bf_lo(w0.z) * 8.f, bf_hi(w0.z) * 8.f, bf_lo(w0.w) * 8.f, bf_hi(w0.w) * 8.f);
    o.z = pack4_fp8(bf_lo(w1.x) * 8.f, bf_hi(w1.x) * 8.f, bf_lo(w1.y) * 8.f, bf_hi(w1.y) * 8.f); o.w = pack4_fp8(bf_lo(w1.z) * 8.f, bf_hi(w1.z) * 8.f, bf_lo(w1.w) * 8.f, bf_hi(w1.w) * 8.f);
    *(u32x4*)(O8p + (size_t)row * 1024 + c0 + 16 * q) = o; }
  __syncthreads();
}
__device__ __forceinline__ void attn_f8_body(const bf16_t* Qb, const unsigned char* __restrict__ Kf8h, const unsigned char* __restrict__ Vt8h, bf16_t* Ob, int seq, char* lds,
                                             const float* __restrict__ qg, const float* __restrict__ ropeR, const float* __restrict__ ropeC, int t0) {
  const int tid = tid_fresh(), wid = __builtin_amdgcn_readfirstlane(tid >> 6), lane = tid & 63, r32 = lane & 31, hi = lane >> 5;
  constexpr int KSL = 8192, VSL = 8192, VOFF = 4 * KSL;
  char* K_l = lds;
  const unsigned ldsb = (unsigned)(uintptr_t)lds;
  bf16x8 qr[8];
  const bf16_t* Qw = Qb + (long)(wid * QBLK + r32) * LDQ + hi * 8;
#pragma unroll
  for (int d0 = 0; d0 < 8; ++d0) qr[d0] = *reinterpret_cast<const bf16x8*>(Qw + d0 * 16);
  i32x8 qf[2]; int qsc[2];
  q_norm_rope6(qr, qf, qsc, qg, ropeR, ropeC, t0, wid, r32, hi);
  f32x16 o[4] = {}; f32x16 lacc = {};
  const i32x6 ones6 = {0x08208208, (int)0x82082082, 0x20820820, 0x08208208, (int)0x82082082, 0x20820820};
  int koff, voff;
  { const int P = wid * 64 + lane;
    { const int key = P >> 3, c = (P & 7) ^ ((key >> 1) & 7); koff = key * 256 + c * 16; }
    { const int d = P >> 2, c = (P & 3) ^ ((d >> 2) & 3); voff = d * 64 + c * 16; } }
  const char* vr0 = lds + VOFF + r32 * 64 + (((2 * hi) ^ ((r32 >> 2) & 3)) << 4); const char* vr1 = lds + VOFF + r32 * 64 + (((2 * hi + 1) ^ ((r32 >> 2) & 3)) << 4);
  const int one_sc = 0x7f7f7f7f;
#define DMA_K(slot, tile) __builtin_amdgcn_global_load_lds((const unsigned*)(Kf8h + (long)(tile) * (KVBLK * 256) + koff), (LAS unsigned*)(ldsb + (slot) * KSL + wid * 1024), 16, 0, 0)
#define DMA_V(slot, tile) __builtin_amdgcn_global_load_lds((const unsigned*)(Vt8h + (long)(tile) * 8192 + voff), (LAS unsigned*)(ldsb + VOFF + (slot) * VSL + wid * 1024), 16, 0, 0)
#define PVL() asm volatile("s_nop 7\n\tv_mfma_scale_f32_32x32x64_f8f6f4 %0, %1, %2, %0, %3, %4 op_sel_hi:[0,0,0] cbsz:2 blgp:2" : "+v"(lacc) : "v"(pf), "v"(ones6), "v"(psc), "v"(one_sc))
  f32x16 pA0, pA1, pB0, pB1; i32x6 pf; int psc; const int NT = seq / KVBLK;
  i32x8 kf00, kf01, kf10, kf11;
  DMA_K(0, 0); DMA_V(0, 0); DMA_K(1, 1); DMA_K(2, 2);
  asm volatile("s_waitcnt vmcnt(0)" ::: "memory"); __builtin_amdgcn_s_barrier(); SBAR();
  qkt_f6(pA0, pA1, K_l, qf, qsc, r32, hi);
  for (int r = 0; r < 16; ++r) pA0[r] = __builtin_amdgcn_exp2f(pA0[r]);
  DMA_V(1, 1); DMA_K(3, 3); DMA_V(2, 2);
  typedef short v2s_t __attribute__((ext_vector_type(2)));
#define VLD(D0, VS, dst) do { const i32x4 b0_ = *(const i32x4*)(vr0 + (VS) * VSL + (D0) * 2048), b1_ = *(const i32x4*)(vr1 + (VS) * VSL + (D0) * 2048); \
    dst = __builtin_shufflevector(b0_, b1_, 0, 1, 2, 3, 4, 5, 6, 7); } while (0)
#define PVM(D0, vb) do { const i32x6 v6_ = __builtin_shufflevector(vb, vb, 0, 1, 2, 3, 4, 5); const int vs_ = vb[6]; \
    asm volatile("s_nop 1\n\tv_mfma_scale_f32_32x32x64_f8f6f4 %0, %1, %2, %0, %3, %4 op_sel_hi:[0,0,0] cbsz:2 blgp:2" : "+v"(o[D0]) : "v"(pf), "v"(v6_), "v"(psc), "v"(vs_)); } while (0)
#define EXPS(P, lo, hi_) do { for (int r = (lo); r < (hi_); ++r) P[r] = __builtin_amdgcn_exp2f(P[r]); } while (0)
#define KADDR(KS, key, c) (K_l + (KS) * KSL + (key) * 128 + ((((c) + 2 * hi) ^ (((key) >> 1) & 7)) << 4))
#define KLD1(KS, dst, key, c) do { const i32x4 a_ = *(const i32x4*)KADDR(KS, key, c), b_ = *(const i32x4*)KADDR(KS, key, (c) + 1); dst = __builtin_shufflevector(a_, b_, 0, 1, 2, 3, 4, 5, 6, 7); } while (0)
#define KLD(KS) do { KLD1(KS, kf00, r32, 0); KLD1(KS, kf10, 32 + r32, 0); KLD1(KS, kf01, r32, 4); KLD1(KS, kf11, 32 + r32, 4); } while (0)
#define HALF8(PN0, PN1, PO0, PO1, t_, KSN, VS, KD, VD) do { const int tk_ = (t_) + 3 < NT ? (t_) + 3 : NT - 1, tv_ = (t_) + 2 < NT ? (t_) + 2 : NT - 1; \
    DMA_K(KD, tk_); DMA_V(VD, tv_); SBAR(); i32x8 va_, vb_; \
    PN0 = __builtin_amdgcn_mfma_scale_f32_32x32x64_f8f6f4(kf00, qf[0], (f32x16){}, 2, 2, 0, kf00[6], 0, qsc[0]); asm volatile("" : "+v"(PN0)); SBAR(); \
    EXPS(PO1, 0, 8); SBAR(); \
    PN1 = __builtin_amdgcn_mfma_scale_f32_32x32x64_f8f6f4(kf10, qf[0], (f32x16){}, 2, 2, 0, kf10[6], 0, qsc[0]); asm volatile("" : "+v"(PN1)); SBAR(); \
    EXPS(PO1, 8, 16); VLD(0, VS, va_); SBAR(); \
    PN0 = __builtin_amdgcn_mfma_scale_f32_32x32x64_f8f6f4(kf01, qf[1], PN0, 2, 2, 0, kf01[6], 0, qsc[1]); asm volatile("" : "+v"(PN0)); SBAR(); \
    float pm_ = 0, pn_ = 0; for (int r = 0; r < 16; ++r) pm_ = fmaxf(pm_, PO0[r]); for (int r = 0; r < 16; ++r) pn_ = fmaxf(pn_, PO1[r]); pm_ = fmaxf(pm_, pn_); \
    const unsigned e8_ = ((__float_as_uint(pm_) >> 23) & 0xffu) - 2u; const float qs_ = __uint_as_float(e8_ << 23); \
    VLD(1, VS, vb_); SBAR(); \
    PN1 = __builtin_amdgcn_mfma_scale_f32_32x32x64_f8f6f4(kf11, qf[1], PN1, 2, 2, 0, kf11[6], 0, qsc[1]); asm volatile("" : "+v"(PN1)); SBAR(); \
    pf = __builtin_bit_cast(i32x6, __builtin_amdgcn_cvt_scalef32_2xpk16_fp6_f32(PO0, PO1, qs_)); psc = (int)(e8_ * 0x01010101u); SBAR(); \
    PVL(); SBAR(); KLD1(KSN, kf00, r32, 0); EXPS(PN0, 0, 4); SBAR(); \
    PVM(0, va_); SBAR(); VLD(2, VS, va_); KLD1(KSN, kf10, 32 + r32, 0); EXPS(PN0, 4, 8); SBAR(); \
    PVM(1, vb_); SBAR(); VLD(3, VS, vb_); KLD1(KSN, kf01, r32, 4); EXPS(PN0, 8, 12); SBAR(); \
    PVM(2, va_); SBAR(); KLD1(KSN, kf11, 32 + r32, 4); EXPS(PN0, 12, 16); SBAR(); \
    PVM(3, vb_); SBAR(); \
    asm volatile("s_waitcnt vmcnt(3)" ::: "memory"); __builtin_amdgcn_s_barrier(); SBAR(); } while (0)
  KLD(1);
  __builtin_amdgcn_s_barrier(); SBAR();
  int t = 1;
  for (; t + 3 < NT - 3; t += 4) {
    HALF8(pB0, pB1, pA0, pA1, t,     2, 0, 0, 3);
    HALF8(pA0, pA1, pB0, pB1, t + 1, 3, 1, 1, 0);
    HALF8(pB0, pB1, pA0, pA1, t + 2, 0, 2, 2, 1);
    HALF8(pA0, pA1, pB0, pB1, t + 3, 1, 3, 3, 2);
  }
  HALF8(pB0, pB1, pA0, pA1, t,     2, 0, 0, 3);
  HALF8(pA0, pA1, pB0, pB1, t + 1, 3, 1, 1, 0);
  HALF8(pB0, pB1, pA0, pA1, t + 2, 0, 2, 2, 1);
  for (int r = 0; r < 16; ++r) pB1[r] = __builtin_amdgcn_exp2f(pB1[r]);
  { float pm_ = 0; for (int r = 0; r < 16; ++r) pm_ = fmaxf(pm_, pB0[r]); for (int r = 0; r < 16; ++r) pm_ = fmaxf(pm_, pB1[r]);
    const unsigned e8_ = ((__float_as_uint(pm_) >> 23) & 0xffu) - 2u;
    pf = __builtin_bit_cast(i32x6, __builtin_amdgcn_cvt_scalef32_2xpk16_fp6_f32(pB0, pB1, __uint_as_float(e8_ << 23))); psc = (int)(e8_ * 0x01010101u); }
  SBAR();
  { i32x8 va_, vb_; VLD(0, 3, va_); VLD(1, 3, vb_); PVL(); PVM(0, va_); PVM(1, vb_); VLD(2, 3, va_); VLD(3, 3, vb_); PVM(2, va_); PVM(3, vb_); }
  asm volatile("s_nop 15\n\ts_nop 15\n\ts_nop 15\n\ts_nop 15\n\ts_nop 15" ::: "memory");
  float rli[16];
#pragma unroll
  for (int r = 0; r < 16; ++r) rli[r] = __builtin_amdgcn_rcpf(lacc[r]);
  if (MIX_F8) {
    unsigned char* O8w = (unsigned char*)Ob + (long)(wid * QBLK) * 1024;
#pragma unroll
    for (int r = 0; r < 16; ++r) { const int orow = crow(r, hi); const float sc8 = rli[r] * 8.0f;
      *(unsigned*)(O8w + (long)orow * 1024 + 4 * r32) = pack4_fp8(o[0][r] * sc8, o[1][r] * sc8, o[2][r] * sc8, o[3][r] * sc8); }
  } else {
  bf16_t* Ow = Ob + (long)(wid * QBLK) * LDQ;
#pragma unroll
  for (int r = 0; r < 16; ++r) { int orow = crow(r, hi);
    *(u32x2*)(Ow + (long)orow * LDQ + 4 * r32) = (u32x2){cvt_pk_bf16(o[0][r] * rli[r], o[1][r] * rli[r]), cvt_pk_bf16(o[2][r] * rli[r], o[3][r] * rli[r])}; }
  }
  asm volatile("s_waitcnt vmcnt(0) lgkmcnt(0)" ::: "memory"); __builtin_amdgcn_s_barrier(); SBAR();
#undef DMA_K
#undef DMA_V
#undef PV8
#undef PVL
#undef HALF8
#undef VLD
#undef PVM
#undef KLD
#undef KLD1
#undef KADDR
#undef EXPS
}

#ifndef ATT_SGP_MODE
#define ATT_SGP_MODE 1
#endif
#define ATT_SGP() do { if (ATT_SGP_MODE == 1) { __builtin_amdgcn_sched_group_barrier(0x100, 4, 0); \
    __builtin_amdgcn_sched_group_barrier(0x008, 1, 0); __builtin_amdgcn_sched_group_barrier(0x100, 4, 0); __builtin_amdgcn_sched_group_barrier(0x002, 20, 0); \
    __builtin_amdgcn_sched_group_barrier(0x008, 1, 0); __builtin_amdgcn_sched_group_barrier(0x002, 20, 0); \
    __builtin_amdgcn_sched_group_barrier(0x008, 1, 0); __builtin_amdgcn_sched_group_barrier(0x002, 20, 0); \
    __builtin_amdgcn_sched_group_barrier(0x008, 1, 0); __builtin_amdgcn_sched_group_barrier(0x002, 20, 0); } else if (ATT_SGP_MODE == 2) { ATT_SG8(); } } while (0)
template <bool LAG>
__device__ __forceinline__ void attn_f8p_body(const bf16_t* Qb, const unsigned char* __restrict__ Kf8h, const unsigned char* __restrict__ Vt8h, bf16_t* Ob, int seq, char* lds,
                                              const float* __restrict__ qg, const float* __restrict__ ropeR, const float* __restrict__ ropeC, int t0) {
  const int tid = tid_fresh(), wid = __builtin_amdgcn_readfirstlane(tid >> 6), lane = tid & 63, r32 = lane & 31, hi = lane >> 5;
  constexpr int KSL = 8192, VSL = 8192, VOFF = 3 * KSL;
  char* K_l = lds;
  const unsigned ldsb = (unsigned)(uintptr_t)lds;
  bf16x8 qr[8];
  const bf16_t* Qw = Qb + (long)(wid * QBLK + r32) * LDQ + hi * 8;
#pragma unroll
  for (int d0 = 0; d0 < 8; ++d0) qr[d0] = *reinterpret_cast<const bf16x8*>(Qw + d0 * 16);
  i32x8 qf[2];
  q_norm_rope<true>(qr, qf, qg, ropeR, ropeC, t0, wid, r32, hi);
  f32x16 o[4], lacc;
  { float z_ = 0.f; asm volatile("" : "+v"(z_));
#pragma unroll
    for (int r = 0; r < 16; ++r) { o[0][r] = z_; o[1][r] = z_; o[2][r] = z_; o[3][r] = z_; lacc[r] = z_; } }
  const i32x8 ones8 = {0x38383838, 0x38383838, 0x38383838, 0x38383838, 0x38383838, 0x38383838, 0x38383838, 0x38383838};
  int koff, voff;
  { const int P = wid * 64 + lane;
    { const int key = P >> 3, c = (P & 7) ^ ((key >> 1) & 7); koff = key * 256 + c * 16; }
    { const int d = P >> 2, c = (P & 3) ^ ((d >> 2) & 3); voff = d * 64 + c * 16; } }
  const unsigned vr0 = ldsb + VOFF + r32 * 64 + (((2 * hi) ^ ((r32 >> 2) & 3)) << 4), vr1 = ldsb + VOFF + r32 * 64 + (((2 * hi + 1) ^ ((r32 >> 2) & 3)) << 4);
  const int one_sc = 0x7f7f7f7f;
#define DMA_K(slotoff, tile) __builtin_amdgcn_global_load_lds((const unsigned*)(Kf8h + (long)(tile) * (KVBLK * 256) + koff), (LAS unsigned*)(ldsb + (slotoff) + wid * 1024), 16, 0, 0)
#define DMA_V(slotoff, tile) __builtin_amdgcn_global_load_lds((const unsigned*)(Vt8h + (long)(tile) * 8192 + voff), (LAS unsigned*)(ldsb + VOFF + (slotoff) + wid * 1024), 16, 0, 0)
#define PVL() asm volatile("s_nop 7\n\tv_mfma_scale_f32_32x32x64_f8f6f4 %0, %1, %2, %0, %3, %4 op_sel_hi:[0,0,0]" : "+v"(lacc) : "v"(pf), "v"(ones8), "v"(psc), "v"(one_sc))
#define PV8(D0, vso) do { const i32x4 b0_ = *(const LAS i32x4*)(vr0 + (vso) + (D0) * 2048), b1_ = *(const LAS i32x4*)(vr1 + (vso) + (D0) * 2048); \
    const i32x8 vb_ = __builtin_shufflevector(b0_, b1_, 0, 1, 2, 3, 4, 5, 6, 7); \
    asm volatile("s_nop 1\n\tv_mfma_scale_f32_32x32x64_f8f6f4 %0, %1, %2, %0, %3, %4 op_sel_hi:[0,0,0]" : "+v"(o[D0]) : "v"(pf), "v"(vb_), "v"(psc), "v"(one_sc)); } while (0)
#define REG_PV(vso, PE) do { PVL(); PV8(0, vso); for (int r = 0; r < 4; ++r) PE[r] = __builtin_amdgcn_exp2f(PE[r]); \
    PV8(1, vso); for (int r = 4; r < 8; ++r) PE[r] = __builtin_amdgcn_exp2f(PE[r]); \
    PV8(2, vso); for (int r = 8; r < 12; ++r) PE[r] = __builtin_amdgcn_exp2f(PE[r]); \
    PV8(3, vso); for (int r = 12; r < 16; ++r) PE[r] = __builtin_amdgcn_exp2f(PE[r]); SBAR(); } while (0)
#define REG_QF(PN0, PN1, kso, PO0, PO1) do { SBAR(); qkt_f8(PN0, PN1, K_l + (kso), qf, r32, hi); finishSM_f8(PO0, PO1, pf, psc); ATT_SGP(); SBAR(); } while (0)
  f32x16 pA0, pA1, pB0, pB1; i32x8 pf; int psc; const int NT = seq / KVBLK;
  DMA_K(0, 0); DMA_V(0, 0); DMA_K(KSL, 1);
  asm volatile("s_waitcnt vmcnt(0)" ::: "memory"); __builtin_amdgcn_s_barrier(); SBAR();
  qkt_f8(pA0, pA1, K_l, qf, r32, hi);
  if constexpr (!LAG) { for (int r = 0; r < 16; ++r) pA0[r] = __builtin_amdgcn_exp2f(pA0[r]); }
  DMA_K(2 * KSL, 2); DMA_V(VSL, 1);
  __builtin_amdgcn_s_barrier(); SBAR();
#define STEP(PN0, PN1, PO0, PO1, t_) do { const int tt_ = (t_), tk_ = tt_ + 2 < NT ? tt_ + 2 : NT - 1, tv_ = tt_ + 1 < NT ? tt_ + 1 : NT - 1; \
    DMA_K(((tt_ + 2) % 3) * KSL, tk_); DMA_V(((tt_ + 1) & 3) * VSL, tv_); \
    if constexpr (!LAG) { REG_QF(PN0, PN1, (tt_ % 3) * KSL, PO0, PO1); REG_PV(((tt_ - 1) & 3) * VSL, PN0); } \
    else { if (tt_ >= 2) { REG_PV(((tt_ - 2) & 3) * VSL, PO0); } else { for (int r = 0; r < 16; ++r) PO0[r] = __builtin_amdgcn_exp2f(PO0[r]); SBAR(); } \
           REG_QF(PN0, PN1, (tt_ % 3) * KSL, PO0, PO1); } \
    asm volatile("s_waitcnt vmcnt(2)" ::: "memory"); __builtin_amdgcn_s_barrier(); SBAR(); } while (0)
  int t = 1;
  for (; t + 1 < NT; t += 2) { STEP(pB0, pB1, pA0, pA1, t); STEP(pA0, pA1, pB0, pB1, t + 1); }
  STEP(pB0, pB1, pA0, pA1, t);
  if constexpr (!LAG) { finishSM_f8(pB0, pB1, pf, psc); SBAR(); PVL(); PV8(0, ((NT - 1) & 3) * VSL); PV8(1, ((NT - 1) & 3) * VSL); PV8(2, ((NT - 1) & 3) * VSL); PV8(3, ((NT - 1) & 3) * VSL); }
  else { REG_PV(((NT - 2) & 3) * VSL, pB0); finishSM_f8(pB0, pB1, pf, psc); SBAR(); PVL(); PV8(0, ((NT - 1) & 3) * VSL); PV8(1, ((NT - 1) & 3) * VSL); PV8(2, ((NT - 1) & 3) * VSL); PV8(3, ((NT - 1) & 3) * VSL); }
  asm volatile("s_nop 15\n\ts_nop 15\n\ts_nop 15\n\ts_nop 15\n\ts_nop 15" ::: "memory");
  float rli[16];
#pragma unroll
  for (int r = 0; r < 16; ++r) rli[r] = __builtin_amdgcn_rcpf(lacc[r]);
  bf16_t* Ow = Ob + (long)(wid * QBLK) * LDQ;
#pragma unroll
  for (int r = 0; r < 16; ++r) { int orow = crow(r, hi);
    for (int d0 = 0; d0 < 4; ++d0) Ow[(long)orow * LDQ + d0 * 32 + r32] = (bf16_t)(cvt_pk_bf16(o[d0][r] * rli[r], 0.f) & 0xffffu); }
  asm volatile("s_waitcnt vmcnt(0) lgkmcnt(0)" ::: "memory"); __builtin_amdgcn_s_barrier(); SBAR();
#undef DMA_K
#undef DMA_V
#undef PV8
#undef PVL
#undef REG_PV
#undef REG_QF
#undef STEP
}
}

namespace dft {
__device__ __forceinline__ unsigned off_b(unsigned row, unsigned ch) { return 256u * row + 16u * (ch ^ (((row & 3) << 2) | ((row >> 2) & 3))); }
__device__ __forceinline__ unsigned tr_read_addr(unsigned lane, unsigned c, unsigned ks, unsigned t) {
  const unsigned h = lane >> 5, blk = (lane >> 4) & 1, q = (lane & 15) >> 2, p = lane & 3;
  return off_b(16 * ks + 8 * h + 4 * t + q, 4 * c + 2 * blk + (p >> 1)) + 8 * (p & 1);
}
template <int OFF> __device__ __forceinline__ s16x4 tr_rd_o(unsigned a) { s16x4 r; asm volatile("ds_read_b64_tr_b16 %0, %1 offset:%2" : "=&v"(r) : "v"(a), "i"(OFF) : "memory"); return r; }
template <int KS, bool OUT8 = false>
__device__ __forceinline__ void dft_unit(LAS unsigned char* lds, const bf16_t* Amat, const bf16_t* bbase, size_t bstride, bf16_t* obase, size_t ostride, u32x4 (&st)[KS * 16 * 16 / NTHR], const bf16_t* bnext) {
    constexpr int KK = 16 * KS, NLD = KK * 16 / NTHR;
    const int tid = tid_fresh(), wid = tid >> 6, lane = tid & 63, mi = wid & 3, nh = wid >> 2, hi = lane >> 5;
    bf16x8 afr[KS];
#pragma unroll
    for (int ks = 0; ks < KS; ++ks) afr[ks] = *(const bf16x8*)(Amat + (size_t)(32 * mi + (lane & 31)) * KK + 16 * ks + 8 * hi);
    const unsigned ldsb = (unsigned)(uintptr_t)lds;
    unsigned ta[2][2][2];
#pragma unroll
    for (int cc = 0; cc < 2; ++cc)
#pragma unroll
        for (int l_ = 0; l_ < 2; ++l_)
#pragma unroll
            for (int t_ = 0; t_ < 2; ++t_) ta[cc][l_][t_] = ldsb + tr_read_addr(lane, 2 * nh + cc, l_, t_);
    const unsigned wbase = (unsigned)(((tid >> 4) >> 5) * 8192) + off_b((tid >> 4) & 31, tid & 15);
    for (int ch = 0; ch < 4; ++ch) {
        __syncthreads();
#pragma unroll
        for (int i = 0; i < NLD; ++i) *(LAS u32x4*)(lds + wbase + i * 8192) = st[i];
        if (ch < 3) {
#pragma unroll
            for (int i = 0; i < NLD; ++i) st[i] = *(const u32x4*)(bbase + i * bstride + (ch + 1) * 128);
        } else if (bnext) {
#pragma unroll
            for (int i = 0; i < NLD; ++i) st[i] = *(const u32x4*)(bnext + i * bstride);
        }
        __syncthreads();
        f32x16 acc0 = {}, acc1 = {};
#define DFT_STEP(ks) { constexpr int o_ = ((ks) >> 1) * 8192; constexpr int l_ = (ks) & 1; \
            const s16x4 a0 = tr_rd_o<o_>(ta[0][l_][0]), a1 = tr_rd_o<o_>(ta[0][l_][1]), b0 = tr_rd_o<o_>(ta[1][l_][0]), b1 = tr_rd_o<o_>(ta[1][l_][1]); \
            asm volatile("s_waitcnt lgkmcnt(0)" ::: "memory"); __builtin_amdgcn_sched_barrier(0); \
            acc0 = __builtin_amdgcn_mfma_f32_32x32x16_bf16(afr[ks], (bf16x8){a0[0], a0[1], a0[2], a0[3], a1[0], a1[1], a1[2], a1[3]}, acc0, 0, 0, 0); \
            acc1 = __builtin_amdgcn_mfma_f32_32x32x16_bf16(afr[ks], (bf16x8){b0[0], b0[1], b0[2], b0[3], b1[0], b1[1], b1[2], b1[3]}, acc1, 0, 0, 0); }
        DFT_STEP(0) DFT_STEP(1) DFT_STEP(2) DFT_STEP(3) DFT_STEP(4) DFT_STEP(5) DFT_STEP(6) DFT_STEP(7)
        if constexpr (KS == 16) { DFT_STEP(8) DFT_STEP(9) DFT_STEP(10) DFT_STEP(11) DFT_STEP(12) DFT_STEP(13) DFT_STEP(14) DFT_STEP(15) }
#undef DFT_STEP
        { LAS unsigned char* stg = lds + 65536 + wid * 4608; const int l_ = lane & 31, row2 = lane >> 1, half = lane & 1;
          if constexpr (OUT8) {
#pragma unroll
            for (int r = 0; r < 16; ++r) { const int row = (r & 3) + 8 * (r >> 2) + 4 * hi; const unsigned w = pack4_fp8(acc0[r], acc1[r], 0.f, 0.f);
                stg[row * 80 + l_] = (unsigned char)(w & 0xffu); stg[row * 80 + 32 + l_] = (unsigned char)((w >> 8) & 0xffu); }
            asm volatile("s_waitcnt lgkmcnt(0)" ::: "memory");
            const u32x4 q0 = *(const LAS u32x4*)(stg + row2 * 80 + half * 32), q1 = *(const LAS u32x4*)(stg + row2 * 80 + half * 32 + 16);
            unsigned char* g = (unsigned char*)obase - (size_t)(4 * hi) * ostride - l_ + (size_t)row2 * ostride + ch * 128 + 64 * nh + half * 32;
            *(u32x4*)g = q0; *(u32x4*)(g + 16) = q1;
          } else {
#pragma unroll
            for (int r = 0; r < 16; ++r) { const int row = (r & 3) + 8 * (r >> 2) + 4 * hi;
                *(LAS unsigned short*)(stg + row * 144 + 2 * l_) = (unsigned short)(cvt_pk_bf16(acc0[r], 0.f) & 0xffffu); *(LAS unsigned short*)(stg + row * 144 + 64 + 2 * l_) = (unsigned short)(cvt_pk_bf16(acc1[r], 0.f) & 0xffffu); }
            asm volatile("s_waitcnt lgkmcnt(0)" ::: "memory");
            bf16_t* g = obase - (size_t)(4 * hi) * ostride - l_ + (size_t)row2 * ostride + ch * 128 + 64 * nh + half * 32;
#pragma unroll
            for (int k = 0; k < 4; ++k) *(u32x4*)(g + 8 * k) = *(const LAS u32x4*)(stg + row2 * 144 + half * 64 + 16 * k);
          }
          asm volatile("s_waitcnt lgkmcnt(0)" ::: "memory");
        }
    }
    __syncthreads();
}
}

struct Args { const float* in[20]; float* out; unsigned char* ws; };
struct Frame {
    LAS unsigned char* lds; int tid, lane, wave, vcu, G; unsigned char* ws;
    __device__ __forceinline__ void fresh() { tid = tid_fresh(); lane = tid & 63; wave = __builtin_amdgcn_readfirstlane(tid >> 6); }
};

__device__ __forceinline__ void p0_transpose_item(const float* W, int ldw, int K, int k0, int nsrc0, bf16_t* WT, int drow0, LAS float* scr, int lane) {
#pragma unroll 8
    for (int i = 0; i < 32; ++i) { const int kk = 2 * i + (lane >> 5); scr[kk * 33 + (lane & 31)] = W[(size_t)(k0 + kk) * ldw + nsrc0 + (lane & 31)]; }
    LDS_WAIT(); asm volatile("" ::: "memory");
    const int c = lane & 7;
#pragma unroll
    for (int j = 0; j < 4; ++j) { const int n = (lane >> 3) + 8 * j; const LAS float* s = scr + (8 * c) * 33 + n;
        u32x4 o; o.x = cvt_pk_bf16(s[0 * 33], s[1 * 33]); o.y = cvt_pk_bf16(s[2 * 33], s[3 * 33]); o.z = cvt_pk_bf16(s[4 * 33], s[5 * 33]); o.w = cvt_pk_bf16(s[6 * 33], s[7 * 33]);
        *(u32x4*)(WT + (size_t)(drow0 + n) * K + k0 + 8 * c) = o; }
    LDS_WAIT(); asm volatile("" ::: "memory");
}

__device__ __forceinline__ void p0_transpose_item_f8(const float* W, int ldw, int K, int k0, int nsrc0, unsigned char* WT, int drow0, float sc, LAS float* scr, int lane) {
#pragma unroll 8
    for (int i = 0; i < 32; ++i) { const int kk = 2 * i + (lane >> 5); scr[kk * 33 + (lane & 31)] = W[(size_t)(k0 + kk) * ldw + nsrc0 + (lane & 31)]; }
    LDS_WAIT(); asm volatile("" ::: "memory");
    const int c = lane & 3;
#pragma unroll
    for (int j = 0; j < 2; ++j) { const int n = (lane >> 2) + 16 * j; const LAS float* s = scr + (16 * c) * 33 + n;
        u32x4 o; o.x = pack4_fp8(s[0 * 33] * sc, s[1 * 33] * sc, s[2 * 33] * sc, s[3 * 33] * sc); o.y = pack4_fp8(s[4 * 33] * sc, s[5 * 33] * sc, s[6 * 33] * sc, s[7 * 33] * sc);
        o.z = pack4_fp8(s[8 * 33] * sc, s[9 * 33] * sc, s[10 * 33] * sc, s[11 * 33] * sc); o.w = pack4_fp8(s[12 * 33] * sc, s[13 * 33] * sc, s[14 * 33] * sc, s[15 * 33] * sc);
        *(u32x4*)(WT + (size_t)(drow0 + n) * K + k0 + 16 * c) = o; }
    LDS_WAIT(); asm volatile("" ::: "memory");
}
__device__ __forceinline__ void p0_prologue(Frame& F, const Args& a) {
    F.fresh();
    const float* c_in = a.in[1]; const float* w_ada = a.in[2]; const float* b_ada = a.in[3]; const float* w_in = a.in[4];
    const float* w_fourier = a.in[7]; const float* w_attn_o = a.in[8]; const float* w_out = a.in[9]; const float* w_gu = a.in[14]; const float* w_dn = a.in[16];
    unsigned char* ws = F.ws;
    LAS float* scr = (LAS float*)(F.lds + F.wave * 8448);
    LAS float* silu = (LAS float*)(F.lds + 73728);
    LAS float* ctab = (LAS float*)(F.lds + 73728 + 32768);
    LAS float* stab = ctab + 128;
    for (int i = F.tid; i < 8192; i += NTHR) { const float v = c_in[i]; silu[i] = v * sigmoidf_(v); }
    if (F.tid < 128) { ctab[F.tid] = cospif((float)F.tid * (1.0f / 64.0f)); stab[F.tid] = sinpif((float)F.tid * (1.0f / 64.0f)); }
    __syncthreads();
    const int gw = F.vcu * NWAVES + F.wave, NGW = F.G * NWAVES;
    if (gw == 0) {
        float gq_ = fmaxf(fabsf(a.in[5][F.lane]), fabsf(a.in[5][64 + F.lane])), gk_ = fmaxf(fabsf(a.in[6][F.lane]), fabsf(a.in[6][64 + F.lane]));
#pragma unroll
        for (int o_ = 1; o_ < 64; o_ <<= 1) { gq_ = fmaxf(gq_, __shfl_xor(gq_, o_)); gk_ = fmaxf(gk_, __shfl_xor(gk_, o_)); }
        if (F.lane == 0) *(float*)(ws + WS_CTL + 61 * 1024) = 11.313708498984761f * gq_ * gk_ * 1.01f; }
    constexpr int I_IN = 16 * 112, I_F = 8 * 32, I_AO = 16 * 32, I_OUT = 16 * 32, I_GU = NE * 16 * 64, I_DN = NE * 16 * 32;
    constexpr int NITEMS = I_IN + I_F + I_AO + I_OUT + I_GU + I_DN;
    for (int it = gw; it < NITEMS; it += NGW) {
        int r = it;
        if (r < I_IN) { const int kb = r / 112, nb = r % 112;
            if (INPROJ_F8) p0_transpose_item_f8(w_in, 4096, 1024, 64 * kb, 512 + 32 * nb, ws + WS_WIN, 1024 + 32 * nb, 32.0f, scr, F.lane);
            else p0_transpose_item(w_in, 4096, 1024, 64 * kb, 512 + 32 * nb, (bf16_t*)(ws + WS_WIN), 1024 + 32 * nb, scr, F.lane);
            continue; } r -= I_IN;
        if (r < I_F) { const int kb = r / 32, nb = r % 32; if (MIX_F8) p0_transpose_item_f8(w_fourier, 1024, 512, 64 * kb, 32 * nb, ws + WS_WF, 32 * nb, 16.0f, scr, F.lane); else p0_transpose_item(w_fourier, 1024, 512, 64 * kb, 32 * nb, (bf16_t*)(ws + WS_WF), 32 * nb, scr, F.lane); continue; } r -= I_F;
        if (r < I_AO) { const int kb = r / 32, nb = r % 32; if (MIX_F8) p0_transpose_item_f8(w_attn_o, 1024, 1024, 64 * kb, 32 * nb, ws + WS_WAO, 32 * nb, 32.0f, scr, F.lane); else p0_transpose_item(w_attn_o, 1024, 1024, 64 * kb, 32 * nb, (bf16_t*)(ws + WS_WAO), 32 * nb, scr, F.lane); continue; } r -= I_AO;
        if (r < I_OUT) { const int kb = r / 32, nb = r % 32; if (MIX_F8) p0_transpose_item_f8(w_out, 1024, 1024, 64 * kb, 32 * nb, ws + WS_WOUT, 32 * nb, 32.0f, scr, F.lane); else p0_transpose_item(w_out, 1024, 1024, 64 * kb, 32 * nb, (bf16_t*)(ws + WS_WOUT), 32 * nb, scr, F.lane); continue; } r -= I_OUT;
        if (r < I_GU) { const int e = r / 1024, q = r % 1024, kb = q / 64, nb = q % 64; const int n0 = 32 * nb, j = n0 & 1023, isup = n0 >> 10;
            p0_transpose_item_f8(w_gu + (size_t)e * 1024 * 2048, 2048, 1024, 64 * kb, n0, (ws + WS_WGU) + (size_t)e * 2048 * 1024, (j >> 7) * 256 + isup * 128 + (j & 127), 32.0f, scr, F.lane); continue; } r -= I_GU;
        { const int e = r / 512, q = r % 512, kb = q / 32, nb = q % 32;
            p0_transpose_item_f8(w_dn + (size_t)e * 1024 * 1024, 1024, 1024, 64 * kb, 32 * nb, (ws + WS_WD) + (size_t)e * 1024 * 1024, 32 * nb, 32.0f, scr, F.lane); }
    }
    for (int it = gw; it < 2048; it += NGW) {
        const int rg = it >> 7, kg = it & 127, r = rg * 64 + F.lane, ri = r >> 9, gI = (r >> 7) & 3, j = r & 127, k0 = kg * 8;
        float acc[8];
#pragma unroll
        for (int kk = 0; kk < 8; ++kk) acc[kk] = 0.f;
        const LAS float* tb = ri ? stab : ctab;
#pragma unroll 8
        for (int c = 0; c < 128; ++c) { const float t = tb[(c * j) & 127];
#pragma unroll
            for (int kk = 0; kk < 8; ++kk) acc[kk] = fmaf(w_in[(size_t)(k0 + kk) * 4096 + gI * 128 + c], t, acc[kk]); }
        const float sc = 0.08838834764831845f;
        if (INPROJ_F8) { const float s8 = sc * 32.0f;
            *(u32x2*)(ws + WS_WIN + (size_t)r * 1024 + k0) = (u32x2){pack4_fp8(acc[0] * s8, acc[1] * s8, acc[2] * s8, acc[3] * s8), pack4_fp8(acc[4] * s8, acc[5] * s8, acc[6] * s8, acc[7] * s8)}; }
        else {
        u32x4 o; o.x = cvt_pk_bf16(acc[0] * sc, acc[1] * sc); o.y = cvt_pk_bf16(acc[2] * sc, acc[3] * sc); o.z = cvt_pk_bf16(acc[4] * sc, acc[5] * sc); o.w = cvt_pk_bf16(acc[6] * sc, acc[7] * sc);
        *(u32x4*)((bf16_t*)(ws + WS_WIN) + (size_t)r * 1024 + k0) = o; }
    }
    const int gt = F.vcu * NTHR + F.tid, NGT = F.G * NTHR;
    for (int i = gt; i < 128 * 128; i += NGT) {
        const int m = i >> 7, kap = i & 127, k1 = m & 63, ro = m >> 6, s1 = kap >> 1, ri = kap & 1, idx = (k1 * s1) & 63;
        const float cs = cospif((float)idx * (1.0f / 32.0f)), sn = sinpif((float)idx * (1.0f / 32.0f));
        const float v = (ro == 0 ? (ri == 0 ? cs : -sn) : (ri == 0 ? -sn : -cs)) * 0.125f;
        ((bf16_t*)(ws + WS_M1))[i] = (bf16_t)(cvt_pk_bf16(v, 0.f) & 0xffffu);
    }
    for (int i = gt; i < 64 * 128 * 32; i += NGT) {
        const int k1 = i >> 12, k2 = (i >> 5) & 127, s20 = (i & 31) * 4; float v[8];
#pragma unroll
        for (int q = 0; q < 4; ++q) { const int n = ((k1 + 64 * k2) * (s20 + q)) & 8191; const float x = (float)n * (1.0f / 4096.0f);
            v[2 * q] = cospif(x) * 0.08838834764831845f; v[2 * q + 1] = sinpif(x) * 0.08838834764831845f; }
        u32x4 o; o.x = cvt_pk_bf16(v[0], v[1]); o.y = cvt_pk_bf16(v[2], v[3]); o.z = cvt_pk_bf16(v[4], v[5]); o.w = cvt_pk_bf16(v[6], v[7]);
        *(u32x4*)((bf16_t*)(ws + WS_ETAB) + (size_t)i * 8) = o;
    }
    for (int i = gt; i < (128 + 64) * 32; i += NGT) {
        const int p = i >> 5, fi = i & 31; const float freq = exp2f(-(float)fi * (13.287712379549449f / 32.0f));
        const float pos = (float)(p < 128 ? p : p - 128); const float ang = pos * freq;
        float* dst = (p < 128) ? (float*)(ws + WS_ROPE_R) + (p * 32 + fi) * 2 : (float*)(ws + WS_ROPE_C) + ((p - 128) * 32 + fi) * 2;
        dst[0] = cosf(ang); dst[1] = sinf(ang);
    }
    __syncthreads();
    LAS float* red = (LAS float*)F.lds;
    for (int it = F.vcu; it < 96; it += F.G) {
        const int col = it * 64 + F.lane; float acc[8];
#pragma unroll
        for (int b = 0; b < 8; ++b) acc[b] = 0.f;
        const int kb = F.wave * 128;
#pragma unroll 16
        for (int k = 0; k < 128; ++k) { const float w = w_ada[(size_t)(kb + k) * 6144 + col];
#pragma unroll
            for (int b = 0; b < 8; ++b) acc[b] = fmaf(silu[b * 1024 + kb + k], w, acc[b]); }
#pragma unroll
        for (int b = 0; b < 8; ++b) red[(F.wave * 8 + b) * 64 + F.lane] = acc[b];
        __syncthreads();
        { const int b = F.wave; float sum = b_ada[col];
#pragma unroll
            for (int w8 = 0; w8 < 8; ++w8) sum += red[(w8 * 8 + b) * 64 + F.lane];
            ((float*)(ws + WS_MOD))[b * 6144 + col] = sum; }
        __syncthreads();
    }
}

__device__ __forceinline__ void p1_adaln(Frame& F, const float* x) {
    F.fresh();
    const float* mod = (const float*)(F.ws + WS_MOD); bf16_t* U = (bf16_t*)(F.ws + WS_U);
    const int gw = F.vcu * NWAVES + F.wave, NGW = F.G * NWAVES;
    const int per = (NTOK + NGW - 1) / NGW; int bcur = -1; f32x4 shr[4], scr[4];
    const int m_end = (gw + 1) * per < NTOK ? (gw + 1) * per : NTOK;
    f32x4 nxr[2][4];
#pragma unroll
    for (int p = 0; p < 2; ++p) if (gw * per + p < m_end) {
#pragma unroll
        for (int j = 0; j < 4; ++j) nxr[p][j] = ((const f32x4*)(x + (size_t)(gw * per + p) * D) + F.lane)[64 * j]; }
    for (int m = gw * per; m < m_end; ++m) {
        const int b = m / SEQ;
        if (b != bcur) { bcur = b; const f32x4* shp = (const f32x4*)(mod + b * 6144) + F.lane; const f32x4* scp = (const f32x4*)(mod + b * 6144 + 1024) + F.lane;
#pragma unroll
            for (int j = 0; j < 4; ++j) { shr[j] = shp[64 * j]; scr[j] = scp[64 * j] + 1.0f; } }
        f32x4 v[4]; float s = 0.f;
#pragma unroll
        for (int j = 0; j < 4; ++j) { v[j] = nxr[0][j]; nxr[0][j] = nxr[1][j]; s += (v[j][0] + v[j][1]) + (v[j][2] + v[j][3]); }
        if (m + 2 < m_end) {
#pragma unroll
            for (int j = 0; j < 4; ++j) nxr[1][j] = ((const f32x4*)(x + (size_t)(m + 2) * D) + F.lane)[64 * j]; }
        const float mean = wave_sum(s) * (1.f / D); float s2 = 0.f;
#pragma unroll
        for (int j = 0; j < 4; ++j) { v[j] = v[j] - mean; s2 += (v[j][0] * v[j][0] + v[j][1] * v[j][1]) + (v[j][2] * v[j][2] + v[j][3] * v[j][3]); }
        const float rstd = 1.f / sqrtf(wave_sum(s2) * (1.f / D) + 1e-6f);
        u32x2* o8 = (u32x2*)(U + (size_t)m * D) + F.lane; unsigned* o4 = (unsigned*)((unsigned char*)U + (size_t)m * D) + F.lane;
#pragma unroll
        for (int j = 0; j < 4; ++j) { const f32x4 y = v[j] * rstd * scr[j] + shr[j];
            if (INPROJ_F8) o4[64 * j] = pack4_fp8(y[0], y[1], y[2], y[3]);
            else o8[64 * j] = (u32x2){cvt_pk_bf16(y[0], y[1]), cvt_pk_bf16(y[2], y[3])}; }
    }
}

__device__ __forceinline__ void p3_qknorm_rope(Frame& F, const float* qg, const float* kg) {
    F.fresh();
    bf16_t* Q = (bf16_t*)(F.ws + WS_Q); bf16_t* Kb = (bf16_t*)(F.ws + WS_K);
    const float* ropeR = (const float*)(F.ws + WS_ROPE_R); const float* ropeC = (const float*)(F.ws + WS_ROPE_C);
    const int gw = F.vcu * NWAVES + F.wave, NGW = F.G * NWAVES, hl = F.lane & 31, hh = F.lane >> 5;
    const int fi0 = 4 * (hl & 7); const bool isx2 = (hl & 8) != 0, iscol = (hl & 16) != 0;
    const f32x4 gq = *(const f32x4*)(qg + 4 * hl), gk = *(const f32x4*)(kg + 4 * hl);
    for (int t4 = gw; t4 < NTOK; t4 += 4 * NGW) {
      u32x2 wq[4]; f32x4 c01q[4], c23q[4];
#pragma unroll
      for (int q = 0; q < 4; ++q) { const int tkn = t4 + q * NGW; if (tkn < NTOK) {
          const int t = tkn % SEQ, prow = t / 64, pcol = t % 64;
          const float* tab = iscol ? ropeC + (pcol * 32 + fi0) * 2 : ropeR + (prow * 32 + fi0) * 2;
          c01q[q] = *(const f32x4*)tab; c23q[q] = *(const f32x4*)(tab + 4); wq[q] = *(const u32x2*)(Kb + (size_t)tkn * 256 + hh * 128 + 4 * hl); } }
#pragma unroll
      for (int q = 0; q < 4; ++q) { const int tkn = t4 + q * NGW; if (tkn >= NTOK) break;
        const f32x4 cs01 = c01q[q], cs23 = c23q[q];
        const float cc[4] = {cs01[0], cs01[2], cs23[0], cs23[2]}, ss[4] = {cs01[1], cs01[3], cs23[1], cs23[3]};
        {
            const int head = 8 + hh;
            bf16_t* p = Kb + (size_t)tkn * 256 + (head - 8) * 128 + 4 * hl;
            const u32x2 w = wq[q];
            float xv[4] = {bf_lo(w.x), bf_hi(w.x), bf_lo(w.y), bf_hi(w.y)};
            float sq = xv[0] * xv[0] + xv[1] * xv[1] + xv[2] * xv[2] + xv[3] * xv[3];
#pragma unroll
            for (int o = 1; o < 32; o <<= 1) sq += __shfl_xor(sq, o);
            const float rstd = 1.0f / sqrtf(sq * (1.0f / 128.0f) + 1e-6f);
            const f32x4 gg = head < 8 ? gq : gk;
            float y[4], yp[4], r[4];
#pragma unroll
            for (int e = 0; e < 4; ++e) { y[e] = xv[e] * rstd * gg[e]; yp[e] = __shfl_xor(y[e], 8); }
#pragma unroll
            for (int e = 0; e < 4; ++e) r[e] = isx2 ? (y[e] * cc[e] + yp[e] * ss[e]) : (y[e] * cc[e] - yp[e] * ss[e]);
            *(u32x2*)p = (u32x2){cvt_pk_bf16(r[0], r[1]), cvt_pk_bf16(r[2], r[3])};
            if (ATT_QK8) {
                const int pos = 64 * (hl >> 4) + 32 * ((hl & 3) >> 1) + 8 * ((hl & 15) >> 2) + 4 * (hl & 1);
                *(unsigned*)(F.ws + WS_KF8 + (size_t)tkn * 256 + (head - 8) * 128 + pos) = pack4_fp8(r[0], r[1], r[2], r[3]); }
            if (ATT_QK6) {
                LAS float* Lk = (LAS float*)(F.lds + 65536) + F.wave * 256 + hh * 128;
                asm volatile("" ::: "memory");
                *(LAS f32x4*)(Lk + 4 * hl) = (f32x4){r[0], r[1], r[2], r[3]};
                asm volatile("s_waitcnt lgkmcnt(0)" ::: "memory"); __builtin_amdgcn_wave_barrier();
                if (hl < 4) { const int s_ = hl >> 1, g_ = hl & 1; f32x16 A, B; float mx = 0.f;
#pragma unroll
                    for (int q4 = 0; q4 < 8; ++q4) { const int d0p = q4 >> 1, j4 = q4 & 1; const f32x4 v = *(LAS f32x4*)(Lk + 64 * s_ + 16 * d0p + 8 * g_ + 4 * j4);
#pragma unroll
                        for (int e = 0; e < 4; ++e) { const int idx = 8 * d0p + 4 * j4 + e; if (idx < 16) A[idx] = v[e]; else B[idx - 16] = v[e]; mx = fmaxf(mx, fabsf(v[e])); } }
                    unsigned e8 = (__float_as_uint(mx) >> 23) & 0xffu; e8 = (e8 < 8u ? 8u : e8) - 2u;
                    const u32x6 p6 = __builtin_amdgcn_cvt_scalef32_2xpk16_fp6_f32(A, B, __uint_as_float(e8 << 23));
                    unsigned char* dst = F.ws + WS_K6 + (size_t)tkn * 256 + (head - 8) * 128 + hl * 32;
                    *(u32x4*)dst = (u32x4){p6[0], p6[1], p6[2], p6[3]}; *(u32x4*)(dst + 16) = (u32x4){p6[4], p6[5], e8 * 0x01010101u, 0u}; }
                asm volatile("s_waitcnt lgkmcnt(0)" ::: "memory"); __builtin_amdgcn_wave_barrier(); }
        }
      }
    }
}


__device__ __forceinline__ void p3_vt8(Frame& F) {
    F.fresh();
    const bf16_t* V = (const bf16_t*)(F.ws + WS_V); unsigned char* VT = F.ws + WS_VT8;
    LAS bf16_t* Ls = (LAS bf16_t*)F.lds;
    u32x4 nv0, nv1;
#define VT_SRC(u_) (V + ((size_t)(((u_) >> 8) * SEQ + ((u_) & 127) * 64)) * 256 + (((u_) >> 7) & 1) * 128 + (size_t)(F.tid >> 3) * 256 + (F.tid & 7) * 16)
    if (F.vcu < BATCH * 2 * 128) { nv0 = *(const u32x4*)VT_SRC(F.vcu); nv1 = *(const u32x4*)(VT_SRC(F.vcu) + 8); }
    for (int u = F.vcu; u < BATCH * 2 * 128; u += F.G) {
        { const int key = F.tid >> 3, c16 = (F.tid & 7) * 16;
          *(LAS u32x4*)(Ls + key * 136 + c16) = nv0; *(LAS u32x4*)(Ls + key * 136 + c16 + 8) = nv1; }
        if (u + F.G < BATCH * 2 * 128) { nv0 = *(const u32x4*)VT_SRC(u + F.G); nv1 = *(const u32x4*)(VT_SRC(u + F.G) + 8); }
        __syncthreads();
#if ATT_PV6
        if (F.tid < 256) { const int d = F.tid >> 1, g = F.tid & 1, ds = 4 * (d & 31) + (d >> 5); f32x16 v0, v1; float mx = 0.f;
#pragma unroll
          for (int r = 0; r < 16; ++r) { const int key = (r & 3) + 8 * (r >> 2) + 4 * g; v0[r] = bf_lo((unsigned)Ls[key * 136 + ds]); v1[r] = bf_lo((unsigned)Ls[(32 + key) * 136 + ds]);
              mx = fmaxf(mx, fmaxf(fabsf(v0[r]), fabsf(v1[r]))); }
          unsigned e8 = (__float_as_uint(mx) >> 23) & 0xffu; e8 = (e8 < 8u ? 8u : e8) - 2u;
          const u32x6 p = __builtin_amdgcn_cvt_scalef32_2xpk16_fp6_f32(v0, v1, __uint_as_float(e8 << 23));
          u32x4 o0, o1; o0.x = p[0]; o0.y = p[1]; o0.z = p[2]; o0.w = p[3]; o1.x = p[4]; o1.y = p[5]; o1.z = e8 * 0x01010101u; o1.w = 0u;
          *(u32x4*)(VT + (size_t)u * 8192 + d * 64 + g * 32) = o0; *(u32x4*)(VT + (size_t)u * 8192 + d * 64 + g * 32 + 16) = o1; }
#else
        { const int d = F.tid >> 2, c = F.tid & 3; float v[16];
#pragma unroll
          for (int mm = 0; mm < 16; ++mm) { const int i = 16 * c + mm, g = i >> 5, m = i & 31, r = m & 15, key = (m >> 4) * 32 + (r & 3) + 8 * (r >> 2) + 4 * g;
              v[mm] = bf_lo((unsigned)Ls[key * 136 + d]); }
          u32x4 o; o.x = pack4_fp8(v[0], v[1], v[2], v[3]); o.y = pack4_fp8(v[4], v[5], v[6], v[7]); o.z = pack4_fp8(v[8], v[9], v[10], v[11]); o.w = pack4_fp8(v[12], v[13], v[14], v[15]);
          *(u32x4*)(VT + (size_t)u * 8192 + d * 64 + c * 16) = o; }
#endif
        __syncthreads();
    }
}
#undef VT_SRC
__device__ __forceinline__ void p7_ln_router(Frame& F, const Args& a) {
    F.fresh();
    const float* ln1g = a.in[10]; const float* ln1b = a.in[11]; const float* w_router = a.in[12]; const float* b_router = a.in[13];
    const float* mod = (const float*)(F.ws + WS_MOD); unsigned char* U2 = F.ws + WS_U2; float* X1 = a.out;
    int* tope = (int*)(F.ws + WS_TOPE); float* topw = (float*)(F.ws + WS_TOPW); int* rank = (int*)(F.ws + WS_RANK); int* hist = (int*)(F.ws + WS_HIST);
    float* st1 = (float*)(F.ws + WS_ST1);
    typedef _Float16 h16x8 __attribute__((ext_vector_type(8)));
    typedef _Float16 h16x4 __attribute__((ext_vector_type(4)));
    LAS _Float16* wT = (LAS _Float16*)F.lds;
    _Float16* U2h = (_Float16*)(F.ws + WS_ACT);
    LAS float* lg = (LAS float*)(F.lds + 131072) + F.wave * 132;
    LAS int* le = (LAS int*)(F.lds + 131072 + 8 * 132 * 4 + 128);
    for (int i = F.tid; i < 32 * 1024; i += NTHR) { const int k = i >> 5, e = i & 31; wT[e * 1032 + k] = (_Float16)w_router[i]; }
    __syncthreads();
    f32x4 g1r[4], b1r[4];
#pragma unroll
    for (int j = 0; j < 4; ++j) { g1r[j] = ((const f32x4*)ln1g)[(j >> 1) * 128 + 2 * F.lane + (j & 1)]; b1r[j] = ((const f32x4*)ln1b)[(j >> 1) * 128 + 2 * F.lane + (j & 1)]; }
    for (int unit = F.vcu; unit < NTOK / 256; unit += F.G) {
        const int b = (unit * 256) / SEQ;
        f32x4 shr[4], scr[4];
#pragma unroll
        for (int j = 0; j < 4; ++j) { shr[j] = ((const f32x4*)(mod + b * 6144 + 3 * 1024))[(j >> 1) * 128 + 2 * F.lane + (j & 1)]; scr[j] = ((const f32x4*)(mod + b * 6144 + 4 * 1024))[(j >> 1) * 128 + 2 * F.lane + (j & 1)] + 1.0f; }
        u32x4 nx[2][2];
        { const int tokp = unit * 256 + F.wave * 32;
#pragma unroll
          for (int q = 0; q < 2; ++q) { const u32x4* xr = (const u32x4*)(X1 + (size_t)(tokp + q) * D) + F.lane;
#pragma unroll
            for (int g = 0; g < 2; ++g) nx[q][g] = xr[64 * g]; } }
        for (int pass = 0; pass < 16; ++pass) {
            const int tok0 = unit * 256 + F.wave * 32 + pass * 2;
            f32x4 uu[2][4];
#pragma unroll
            for (int q = 0; q < 2; ++q)
#pragma unroll
                for (int g = 0; g < 2; ++g) { uu[q][2 * g] = (f32x4){bf_lo(nx[q][g].x), bf_hi(nx[q][g].x), bf_lo(nx[q][g].y), bf_hi(nx[q][g].y)}; uu[q][2 * g + 1] = (f32x4){bf_lo(nx[q][g].z), bf_hi(nx[q][g].z), bf_lo(nx[q][g].w), bf_hi(nx[q][g].w)}; }
            if (pass < 15) {
#pragma unroll
                for (int q = 0; q < 2; ++q) { const u32x4* xr = (const u32x4*)(X1 + (size_t)(tok0 + 2 + q) * D) + F.lane;
#pragma unroll
                    for (int g = 0; g < 2; ++g) nx[q][g] = xr[64 * g]; }
            }
#pragma unroll
            for (int q = 0; q < 2; ++q) {
                f32x4 (&v)[4] = uu[q]; float s = 0.f, s2 = 0.f;
#pragma unroll
                for (int j = 0; j < 4; ++j) { s += (v[j][0] + v[j][1]) + (v[j][2] + v[j][3]); s2 += (v[j][0] * v[j][0] + v[j][1] * v[j][1]) + (v[j][2] * v[j][2] + v[j][3] * v[j][3]); }
                wave_sum2(s, s2);
                float mean = s * (1.f / D); float rstd = 1.f / sqrtf(fmaxf(s2 * (1.f / D) - mean * mean, 0.f) + 1e-5f);
                if (F.lane == 0) *(f32x2*)(st1 + (size_t)(tok0 + q) * 2) = (f32x2){mean, rstd};
                s = 0.f; s2 = 0.f;
#pragma unroll
                for (int j = 0; j < 4; ++j) { v[j] = (v[j] - mean) * rstd * g1r[j] + b1r[j];
                    s += (v[j][0] + v[j][1]) + (v[j][2] + v[j][3]); s2 += (v[j][0] * v[j][0] + v[j][1] * v[j][1]) + (v[j][2] * v[j][2] + v[j][3] * v[j][3]); }
                wave_sum2(s, s2);
                mean = s * (1.f / D); rstd = 1.f / sqrtf(fmaxf(s2 * (1.f / D) - mean * mean, 0.f) + 1e-6f);
#pragma unroll
                for (int j = 0; j < 4; ++j) v[j] = v[j] - mean;
                u32x2* o8 = (u32x2*)(U2 + (size_t)(tok0 + q) * D) + F.lane; h16x8* oh = (h16x8*)(U2h + (size_t)(tok0 + q) * D) + F.lane;
#pragma unroll
                for (int g = 0; g < 2; ++g) { const f32x4 ya = v[2 * g] * rstd * scr[2 * g] + shr[2 * g], yb = v[2 * g + 1] * rstd * scr[2 * g + 1] + shr[2 * g + 1];
                    o8[64 * g] = (u32x2){pack4_fp8(ya[0], ya[1], ya[2], ya[3]), pack4_fp8(yb[0], yb[1], yb[2], yb[3])};
                    oh[64 * g] = (h16x8){(_Float16)ya[0], (_Float16)ya[1], (_Float16)ya[2], (_Float16)ya[3], (_Float16)yb[0], (_Float16)yb[1], (_Float16)yb[2], (_Float16)yb[3]}; }
            }
        }
        VM_WAIT();
        {
            const int tokw = unit * 256 + F.wave * 32, r32 = F.lane & 31, hi = F.lane >> 5;
            const _Float16* arow = U2h + (size_t)(tokw + r32) * D + 8 * hi; const LAS _Float16* brow = wT + r32 * 1032 + 8 * hi;
            f32x16 lacc = {};
#pragma unroll 8
            for (int st = 0; st < 64; ++st) {
                const h16x8 af = *(const h16x8*)(arow + 16 * st); const h16x8 bf = *(const LAS h16x8*)(brow + 16 * st);
                lacc = __builtin_amdgcn_mfma_f32_32x32x16_f16(af, bf, lacc, 0, 0, 0);
            }
            const float br = b_router[r32];
#pragma unroll
            for (int r = 0; r < 16; ++r) {
                const int q = hi, e = r32; const float x = lacc[r] + br;
                lg[q * 32 + e] = x; LDS_WAIT(); asm volatile("" ::: "memory");
                int rk = 0;
#pragma unroll
                for (int c4 = 0; c4 < 8; ++c4) { const f32x4 y = *(const LAS f32x4*)(lg + q * 32 + 4 * c4);
#pragma unroll
                    for (int k = 0; k < 4; ++k) { const int e2 = 4 * c4 + k; rk += (y[k] > x || (y[k] == x && e2 < e)) ? 1 : 0; } }
                if (rk < 4) { lg[64 + q * 8 + rk] = x; lg[64 + q * 8 + 4 + rk] = __int_as_float(e); }
                LDS_WAIT(); asm volatile("" ::: "memory");
                if (e == 0) { const int tl = (r & 3) + 8 * (r >> 2) + 4 * hi, tok = tokw + tl; const f32x4 tv = *(const LAS f32x4*)(lg + 64 + q * 8), tif = *(const LAS f32x4*)(lg + 64 + q * 8 + 4);
                    const int i0 = __float_as_int(tif[0]), i1 = __float_as_int(tif[1]), i2 = __float_as_int(tif[2]), i3 = __float_as_int(tif[3]);
                    const float e1 = __expf(tv[1] - tv[0]), e2 = __expf(tv[2] - tv[0]), e3 = __expf(tv[3] - tv[0]), inv = 1.0f / (1.0f + e1 + e2 + e3);
                    *(int4*)(tope + (size_t)tok * 4) = make_int4(i0, i1, i2, i3);
                    *(f32x4*)(topw + (size_t)tok * 4) = (f32x4){inv, e1 * inv, e2 * inv, e3 * inv};
                    const int sl = (F.wave * 32 + tl) * 4; le[sl] = i0; le[sl + 1] = i1; le[sl + 2] = i2; le[sl + 3] = i3; }
                LDS_WAIT(); asm volatile("" ::: "memory");
            }
        }
        __syncthreads();
#pragma unroll
        for (int rep = 0; rep < 2; ++rep) { const int sl = F.tid + rep * NTHR, me = le[sl]; int r = 0;
            for (int s2 = 0; s2 < sl; ++s2) r += (le[s2] == me) ? 1 : 0;
            rank[(size_t)unit * 1024 + sl] = r; }
        if (F.tid < 32) { int c = 0; for (int s2 = 0; s2 < 1024; ++s2) c += (le[s2] == F.tid) ? 1 : 0; hist[unit * 32 + F.tid] = c; }
        __syncthreads();
    }
}

__device__ __forceinline__ void p8_scatter(Frame& F) {
    F.fresh();
    const int* tope = (const int*)(F.ws + WS_TOPE); const float* topw = (const float*)(F.ws + WS_TOPW); const int* rank = (const int*)(F.ws + WS_RANK); const int* hist = (const int*)(F.ws + WS_HIST);
    int* rowtok = (int*)(F.ws + WS_ROWTOK); int* rowdst = (int*)(F.ws + WS_ROWDST); float* roww = (float*)(F.ws + WS_ROWW); int* tilee = (int*)(F.ws + WS_TILEE);
    LAS int* pre = (LAS int*)F.lds;
    LAS int* cnt = pre + 256 * 32;
    LAS int* pst = cnt + 64;
    constexpr int UPH = (NTOK / 256) / NHALF;
    static_assert((NTOK / 256) == 16 * (NTHR / 32) && UPH % 16 == 0, "two-level scan geometry");
    { LAS int* part = pst + 64;
      const int e = F.tid & 31, c = F.tid >> 5; int hv[16], tot = 0;
#pragma unroll
      for (int i = 0; i < 16; ++i) hv[i] = hist[(16 * c + i) * 32 + e];
#pragma unroll
      for (int i = 0; i < 16; ++i) { const int t_ = hv[i]; hv[i] = tot; tot += t_; }
      part[c * 32 + e] = tot;
      __syncthreads();
      if (F.tid < 32 * NHALF) { const int h = F.tid >> 5; int run = 0;
          for (int cc = 0; cc < UPH / 16; ++cc) { const int ix = (h * (UPH / 16) + cc) * 32 + e; const int t_ = part[ix]; part[ix] = run; run += t_; }
          cnt[F.tid] = run; }
      __syncthreads();
      const int off = part[c * 32 + e];
#pragma unroll
      for (int i = 0; i < 16; ++i) pre[(16 * c + i) * 32 + e] = off + hv[i]; }
    __syncthreads();
    if (F.tid < NHALF) { int run = 0; for (int e = 0; e < 32; ++e) { pst[F.tid * 32 + e] = run; run += (cnt[F.tid * 32 + e] + 255) & ~255; }
        if (F.vcu == 0) tilee[4096 + F.tid] = run / 256; }
    __syncthreads();
    if (F.vcu == 0) {
        for (int i = F.tid; i < NHALF * 32; i += NTHR) { const int h = i >> 5, e = i & 31; const int t0 = pst[i] / 256, t1 = t0 + ((cnt[i] + 255) >> 8);
            for (int t = t0; t < t1; ++t) tilee[h * 2048 + t] = e; }
    }
    for (int pe = F.vcu; pe < NHALF * 32; pe += F.G) {
        const int h = pe >> 5; const int r0 = pst[pe] + cnt[pe], r1 = pst[pe] + ((cnt[pe] + 255) & ~255);
        for (int r = r0 + F.tid; r < r1; r += NTHR) { rowtok[h * MAXROWS_H + r] = 0; rowdst[h * MAXROWS_H + r] = -1; roww[h * MAXROWS_H + r] = 0.f; }
    }
    for (int unit = F.vcu; unit < NTOK / 256; unit += F.G) {
        const int h = unit / UPH;
        for (int s = F.tid; s < 1024; s += NTHR) {
            const int slot = unit * 1024 + s, tok = slot >> 2, e = tope[slot];
            const int row = pst[h * 32 + e] + pre[unit * 32 + e] + rank[slot];
            rowtok[h * MAXROWS_H + row] = tok; rowdst[h * MAXROWS_H + row] = slot - h * (HTOK * 4); roww[h * MAXROWS_H + row] = topw[slot];
        }
    }
    __syncthreads();
}

__device__ __forceinline__ void p_final(Frame& F, const Args& a, int h, float* outp) {
    F.fresh();
    const float* ln2g = a.in[18]; const float* ln2b = a.in[19]; const float* mod = (const float*)(F.ws + WS_MOD); const bf16_t* yb = (const bf16_t*)(F.ws + WS_YB);
    const int gw = F.vcu * NWAVES + F.wave, NGW = F.G * NWAVES;
    f32x4 g2r[4], b2r[4], g1r[4], b1r[4], gmr[4];
#pragma unroll
    for (int j = 0; j < 4; ++j) { g2r[j] = ((const f32x4*)ln2g + F.lane)[64 * j]; b2r[j] = ((const f32x4*)ln2b + F.lane)[64 * j]; g1r[j] = ((const f32x4*)a.in[10] + F.lane)[64 * j]; b1r[j] = ((const f32x4*)a.in[11] + F.lane)[64 * j]; }
    const int per = (HTOK + NGW - 1) / NGW; int bcur = -1;
    for (int tl = gw * per; tl < HTOK && tl < (gw + 1) * per; ++tl) {
        const int tok = h * HTOK + tl, b = tok / SEQ;
        if (b != bcur) { bcur = b;
#pragma unroll
            for (int j = 0; j < 4; ++j) gmr[j] = ((const f32x4*)(mod + b * 6144 + 5 * 1024) + F.lane)[64 * j]; }
        const u32x2* y0 = (const u32x2*)(yb + (size_t)tl * 4 * 1024) + F.lane;
        const f32x2 ms1 = *(const f32x2*)((const float*)(F.ws + WS_ST1) + (size_t)tok * 2); const float m1 = ms1[0], r1 = ms1[1];
        f32x4 v[4], pr[4]; float s = 0.f;
        { const u32x2* p2 = (const u32x2*)(a.out + (size_t)tok * D) + F.lane;
#pragma unroll
          for (int j = 0; j < 4; ++j) { const u32x2 w = p2[64 * j]; pr[j] = (f32x4){bf_lo(w.x), bf_hi(w.x), bf_lo(w.y), bf_hi(w.y)}; } }
#pragma unroll
        for (int j = 0; j < 4; ++j) {
            f32x4 hm = {0.f, 0.f, 0.f, 0.f};
#pragma unroll
            for (int k = 0; k < 4; ++k) { const u32x2 w = y0[k * 256 + 64 * j]; hm += (f32x4){bf_lo(w.x), bf_hi(w.x), bf_lo(w.y), bf_hi(w.y)}; }
            const f32x4 x1 = (pr[j] - m1) * r1 * g1r[j] + b1r[j];
            v[j] = x1 * DN_ALPHA + gmr[j] * hm; s += (v[j][0] + v[j][1]) + (v[j][2] + v[j][3]); }
        const float mean = wave_sum(s) * (1.f / D); float s2 = 0.f;
#pragma unroll
        for (int j = 0; j < 4; ++j) { v[j] = v[j] - mean; s2 += (v[j][0] * v[j][0] + v[j][1] * v[j][1]) + (v[j][2] * v[j][2] + v[j][3] * v[j][3]); }
        const float rstd = 1.f / sqrtf(wave_sum(s2) * (1.f / D) + 1e-5f);
        f32x4* orow = (f32x4*)(outp + (size_t)tok * D) + F.lane;
#pragma unroll
        for (int j = 0; j < 4; ++j) orow[64 * j] = v[j] * rstd * g2r[j] + b2r[j];
    }
}


#define GBAR(n) xcd_barrier(bar)
#define PH(k) 1
__global__ void __launch_bounds__(NTHR, 2) hyb_fwd(Args args) {
    extern __shared__ __attribute__((aligned(16))) unsigned char lds[];
    Frame F;
    F.lds = (LAS unsigned char*)lds; F.fresh();
    F.G = gridDim.x; { const int bx = blockIdx.x; F.vcu = (F.G % 8 == 0) ? (bx % 8) * (F.G / 8) + bx / 8 : bx; }
    F.ws = args.ws;
    volatile LAS unsigned* MISC = (volatile LAS unsigned*)(F.lds + MISC_OFF);
    for (int u = F.tid; u < 64; u += NTHR) ((LAS unsigned*)(F.lds + MISC_OFF))[u] = 0u;
    __syncthreads();
    XcdBarrier bar = xcd_barrier_post((unsigned*)(F.ws + WS_CTL) + CW_BAR, MISC + 8);
    unsigned char* ws = F.ws;
    const float* x = args.in[0];
    const float* mod = (const float*)(ws + WS_MOD);

    if (PH(0)) p0_prologue(F, args);
    GBAR(1);
    if (PH(1)) p1_adaln(F, x);
    GBAR(2);
    {
        pg8::Gemm g{(const bf16_t*)(ws + WS_U), (const bf16_t*)(ws + WS_WIN), nullptr, 1024};
        pg8::DenseOrder S{NTOK / 256, NIN / 256, F.G, (int)blockIdx.x, INPROJ_F8 ? 1024 : 2048};
        pg8::EpiInProj E{(bf16_t*)(ws + WS_H), (bf16_t*)(ws + WS_Q), (bf16_t*)(ws + WS_K), (bf16_t*)(ws + WS_V), (bf16_t*)(ws + WS_G), INPROJ_F8 ? 0.03125f : 1.0f};
        pg8::gemm_phase<pg8::EpiInProj, pg8::DenseOrder, false, ALIGN_P2, INPROJ_F8 != 0>(F.lds, g, S, E);
    }
    GBAR(3);
    if (PH(3)) p3_qknorm_rope(F, args.in[5], args.in[6]);
    if (ATT_PV8) p3_vt8(F);
    if (PH(4)) {
        bf16_t* Hb = (bf16_t*)(ws + WS_H); const bf16_t* M1 = (const bf16_t*)(ws + WS_M1);
        F.fresh();
#define D1_BBASE(u_) (Hb + ((size_t)(((u_) >> 7) * SEQ + (F.tid >> 5) * 128 + ((u_) & 127))) * 1024 + ((F.tid >> 4) & 1) * 512 + (F.tid & 15) * 8)
        u32x4 st1_[4];
        if (F.vcu < BATCH * 128) {
#pragma unroll
            for (int i = 0; i < 4; ++i) st1_[i] = *(const u32x4*)(D1_BBASE(F.vcu) + i * (size_t)16 * 128 * 1024); }
        for (int u = F.vcu; u < BATCH * 128; u += F.G) {
            const int b = u >> 7, s2 = u & 127;
            const bf16_t* bbase = D1_BBASE(u); const bf16_t* bnext = (u + F.G < BATCH * 128) ? D1_BBASE(u + F.G) : nullptr;
            const int mi_ = F.wave & 3, m0_ = 32 * mi_ + 4 * (F.lane >> 5);
            bf16_t* obase = (bf16_t*)(ws + WS_T) + ((size_t)(b * SEQ + (m0_ & 63) * 128 + s2)) * 1024 + (m0_ >> 6) * 512 + (F.lane & 31);
            dft::dft_unit<8>(F.lds, M1, bbase, (size_t)16 * 128 * 1024, obase, (size_t)128 * 1024, st1_, bnext);
        }
    }
    GBAR(4);
    if (PH(5)) {
        bf16_t* Q = (bf16_t*)(ws + WS_Q); const bf16_t* Kb = (const bf16_t*)(ws + WS_K); const bf16_t* Vb = (const bf16_t*)(ws + WS_V);
        const float Mnat = *(const volatile float*)(ws + WS_CTL + 61 * 1024);
        const bool fixed_ok = __builtin_amdgcn_readfirstlane((int)(Mnat < 43.0f)) != 0;
        const float* rR = (const float*)(ws + WS_ROPE_R); const float* rC = (const float*)(ws + WS_ROPE_C);
#define ATT_UNITS(FX) for (int u = F.vcu; u < BATCH * 8 * 32; u += F.G) { \
            const int qb = u & 31, hq = (u >> 5) & 7, b = u >> 8, kvh = hq >> 2; \
            bf16_t* Qp = Q + ((size_t)(b * SEQ + qb * 256)) * 1024 + hq * 128; \
            att::attn_dense_body<FX>(Qp, Kb + (size_t)b * SEQ * 256 + kvh * 128, Vb + (size_t)b * SEQ * 256 + kvh * 128, Qp, SEQ, (char*)lds, args.in[5], rR, rC, qb * 256); \
            if (MIX_F8) att::o_bf16_to_fp8(Qp, ws + WS_U2 + ((size_t)(b * SEQ + qb * 256)) * 1024 + hq * 128); }
        if (fixed_ok && ATT_DMA && ATT_QK8 && ATT_PV8 && ATT_PHASED && (SEQ / 64) % 2 == 0) {
            const int tid_ = tid_fresh(); const bool lag_ = __builtin_amdgcn_readfirstlane(tid_ >> 8) != 0;
#define ATT_PUNITS(LG) for (int u = F.vcu; u < BATCH * 8 * 32; u += F.G) { \
                const int qb = u & 31, hq = (u >> 5) & 7, b = u >> 8, kvh = hq >> 2; \
                bf16_t* Qp = Q + ((size_t)(b * SEQ + qb * 256)) * 1024 + hq * 128; \
                att::attn_f8p_body<LG>(Qp, ws + WS_KF8 + (size_t)b * SEQ * 256 + kvh * 128, ws + WS_VT8 + (size_t)((b * 2 + kvh) * 128) * 8192, Qp, SEQ, (char*)lds, args.in[5], rR, rC, qb * 256); \
                if (MIX_F8) att::o_bf16_to_fp8(Qp, ws + WS_U2 + ((size_t)(b * SEQ + qb * 256)) * 1024 + hq * 128); }
            if (lag_) { ATT_PUNITS(true) } else { ATT_PUNITS(false) }
#undef ATT_PUNITS
        } else if (fixed_ok && ATT_DMA && ATT_QK8 && ATT_PV8 && ((SEQ / 64) % 4 == 0)) {
            for (int u = F.vcu; u < BATCH * 8 * 32; u += F.G) {
                const int qb = u & 31, hq = (u >> 5) & 7, b = u >> 8, kvh = hq >> 2;
                bf16_t* Qp = Q + ((size_t)(b * SEQ + qb * 256)) * 1024 + hq * 128;
                bf16_t* Op = MIX_F8 ? (bf16_t*)(ws + WS_U2 + ((size_t)(b * SEQ + qb * 256)) * 1024 + hq * 128) : Qp;
                att::attn_f8_body(Qp, ws + (ATT_QK6 ? WS_K6 : WS_KF8) + (size_t)b * SEQ * 256 + kvh * 128, ws + WS_VT8 + (size_t)((b * 2 + kvh) * 128) * 8192, Op, SEQ, (char*)lds, args.in[5], rR, rC, qb * 256); }
        } else if (fixed_ok && ATT_DMA && ((SEQ / 64 - 1) % 6 == 1)) {
            for (int u = F.vcu; u < BATCH * 8 * 32; u += F.G) {
                const int qb = u & 31, hq = (u >> 5) & 7, b = u >> 8, kvh = hq >> 2;
                bf16_t* Qp = Q + ((size_t)(b * SEQ + qb * 256)) * 1024 + hq * 128;
                bf16_t* Op = Qp;
                att::attn_dma_body<ATT_QK8 != 0>(Qp, Kb + (size_t)b * SEQ * 256 + kvh * 128, ws + WS_KF8 + (size_t)b * SEQ * 256 + kvh * 128, Vb + (size_t)b * SEQ * 256 + kvh * 128, Op, SEQ, (char*)lds, args.in[5], rR, rC, qb * 256);
                if (MIX_F8 && Op == Qp) att::o_bf16_to_fp8(Qp, ws + WS_U2 + ((size_t)(b * SEQ + qb * 256)) * 1024 + hq * 128); }
        } else if (fixed_ok) { ATT_UNITS(true) } else { ATT_UNITS(false) }
#undef ATT_UNITS
    }
    if (PH(6)) {
        const bf16_t* Tb = (const bf16_t*)(ws + WS_H); bf16_t* Y = (bf16_t*)(ws + WS_U); const bf16_t* Et = (const bf16_t*)(ws + WS_ETAB);
        F.fresh();
#define D3_BBASE(u_) (Tb + ((size_t)(((u_) >> 6) * SEQ + ((u_) & 63) * 128)) * 1024 + (size_t)(F.tid >> 4) * 512 + (F.tid & 15) * 8)
        u32x4 st3_[8];
        if (F.vcu < BATCH * 64) {
#pragma unroll
            for (int i = 0; i < 8; ++i) st3_[i] = *(const u32x4*)(D3_BBASE(F.vcu) + i * (size_t)32 * 512); }
        for (int u = F.vcu; u < BATCH * 64; u += F.G) {
            const int b = u >> 6, k1 = u & 63;
            const bf16_t* bbase = D3_BBASE(u); const bf16_t* bnext = (u + F.G < BATCH * 64) ? D3_BBASE(u + F.G) : nullptr;
            const int m0_ = 32 * (F.wave & 3) + 4 * (F.lane >> 5);
            if (MIX_F8) { unsigned char* ob8 = (unsigned char*)Y + ((size_t)(b * SEQ + k1 + 64 * m0_)) * 512 + (F.lane & 31);
                dft::dft_unit<16, true>(F.lds, Et + (size_t)k1 * 128 * 256, bbase, (size_t)32 * 512, (bf16_t*)ob8, (size_t)64 * 512, st3_, bnext); continue; }
            bf16_t* obase = Y + ((size_t)(b * SEQ + k1 + 64 * m0_)) * 512 + (F.lane & 31);
            dft::dft_unit<16>(F.lds, Et + (size_t)k1 * 128 * 256, bbase, (size_t)32 * 512, obase, (size_t)64 * 512, st3_, bnext);
        }
    }
    GBAR(5);
    if (P5_FUSED) {
        pg8::gemm_p5_fused(F.lds, (const bf16_t*)(ws + WS_U), (const bf16_t*)(ws + WS_WF), (const bf16_t*)(ws + (MIX_F8 ? WS_U2 : WS_Q)), (const bf16_t*)(ws + WS_WAO), (const bf16_t*)(ws + WS_G), (bf16_t*)(ws + WS_H), F.G, (int)blockIdx.x);
    } else
    {
    if (PH(7)) {
        pg8::Gemm g{(const bf16_t*)(ws + WS_U), (const bf16_t*)(ws + WS_WF), nullptr, 512};
        pg8::DenseOrder S{NTOK / 256, 4, F.G, (int)blockIdx.x, 1024};
        pg8::EpiGateF E{(const bf16_t*)(ws + WS_G), (bf16_t*)args.out};
        pg8::gemm_phase<pg8::EpiGateF, pg8::DenseOrder, false, ALIGN_MIX>(F.lds, g, S, E);
    }
    __syncthreads();
    if (PH(8)) {
        pg8::Gemm g{(const bf16_t*)(ws + WS_Q), (const bf16_t*)(ws + WS_WAO), nullptr, 1024};
        pg8::DenseOrder S{NTOK / 256, 4, F.G, (int)blockIdx.x, 2048};
        pg8::EpiGateA E{(const bf16_t*)(ws + WS_G), (const bf16_t*)args.out, (bf16_t*)(ws + WS_H)};
        pg8::gemm_phase<pg8::EpiGateA, pg8::DenseOrder, false, ALIGN_MIX>(F.lds, g, S, E);
    }
    __syncthreads();
    }
    GBAR(6);
    {
        pg8::Gemm g{(const bf16_t*)(ws + WS_H), (const bf16_t*)(ws + WS_WOUT), nullptr, 1024};
        pg8::DenseOrder S{NTOK / 256, 4, F.G, (int)blockIdx.x, MIX_F8 ? 1024 : 2048};
        pg8::EpiOut E{x, mod, args.out, MIX_F8 ? 1.0f / 32.0f : 1.0f};
        pg8::gemm_phase<pg8::EpiOut, pg8::DenseOrder, false, ALIGN_MIX, MIX_F8 != 0>(F.lds, g, S, E);
    }
    GBAR(7);
    if (PH(10)) p7_ln_router(F, args);
    GBAR(8);
    if (PH(11)) p8_scatter(F);
    GBAR(9);
    const int* tilee = (const int*)(ws + WS_TILEE);
    for (int h = 0; h < NHALF; ++h) {
        const int ntiles = __builtin_amdgcn_readfirstlane(tilee[4096 + h]);
        if (h > 0 && PH(14)) p_final(F, args, h - 1, args.out);
        {
            pg8::Gemm g{(const bf16_t*)(ws + WS_U2), (const bf16_t*)(ws + WS_WGU), (const int*)(ws + WS_ROWTOK) + h * MAXROWS_H, 1024};
            pg8::MoeOrder S{ntiles, 8, F.G, (int)blockIdx.x, 1024, tilee + h * 2048, (size_t)2048 * 1024};
            pg8::EpiSwiglu E{args.in[15], ws + WS_ACT};
            pg8::gemm_phase<pg8::EpiSwiglu, pg8::MoeOrder, true, ALIGN_UP, true>(F.lds, g, S, E);
        }
        GBAR(10);
        {
            pg8::Gemm g{(const bf16_t*)(ws + WS_ACT), (const bf16_t*)(ws + WS_WD), nullptr, 1024};
            pg8::MoeOrder S{ntiles, 4, F.G, (int)blockIdx.x, 1024, tilee + h * 2048, (size_t)1024 * 1024};
            pg8::EpiDown E{args.in[17], (const int*)(ws + WS_ROWDST) + h * MAXROWS_H, (const float*)(ws + WS_ROWW) + h * MAXROWS_H, (bf16_t*)(ws + WS_YB)};
            pg8::gemm_phase<pg8::EpiDown, pg8::MoeOrder, false, ALIGN_DN, true>(F.lds, g, S, E);
        }
        GBAR(11);
    }
    if (PH(14)) p_final(F, args, NHALF - 1, args.out);
}

extern "C" void kernel_launch(void* const* d_in, const int* in_sizes, int n_in, void* d_out, int out_size, void* d_ws, size_t ws_size, hipStream_t stream) {
    static int grid = 0;
    if (grid == 0) {
        if (n_in != 20 || out_size != NTOK * D || ws_size < WS_END) { fprintf(stderr, "kernel_launch: unexpected shapes (n_in %d out %d ws %zu)\n", n_in, out_size, ws_size); grid = -1; return; }
        int dev = 0, cus = 0;
        if (hipGetDevice(&dev) != hipSuccess || hipDeviceGetAttribute(&cus, hipDeviceAttributeMultiprocessorCount, dev) != hipSuccess) { grid = -1; return; }
        if (hipFuncSetAttribute((const void*)hyb_fwd, hipFuncAttributeMaxDynamicSharedMemorySize, LDS_BYTES) != hipSuccess) { fprintf(stderr, "kernel_launch: hipFuncSetAttribute failed\n"); grid = -1; return; }
        int per_cu = 0;
        if (hipOccupancyMaxActiveBlocksPerMultiprocessor(&per_cu, (const void*)hyb_fwd, NTHR, LDS_BYTES) != hipSuccess || per_cu < 1) { fprintf(stderr, "kernel_launch: occupancy query says %d\n", per_cu); }
        (void)hipGetLastError();
        grid = cus;
    }
    if (grid < 0) return;
    if (hipMemsetAsync((char*)d_ws + WS_CTL, 0, CTL_ZERO_BYTES, stream) != hipSuccess) return;
    Args a{};
    for (int i = 0; i < 20; ++i) a.in[i] = (const float*)d_in[i];
    a.out = (float*)d_out; a.ws = (unsigned char*)d_ws;
    hipLaunchKernelGGL(hyb_fwd, dim3(grid), dim3(NTHR), LDS_BYTES, stream, a);
}
```

```cpp
#include <hip/hip_runtime.h>
#include <cstdio>
#include <cstdint>

#ifndef INPROJ_F8
#define INPROJ_F8 1
#endif
#ifndef P5_FUSED
#define P5_FUSED 1
#endif
#ifndef GATE_F8
#define GATE_F8 1
#endif
#ifndef YB_F8
#define YB_F8 1
#endif
#ifndef MIX_F8
#define MIX_F8 1
#endif
#ifndef ALIGN_P2
#define ALIGN_P2 true
#endif
#ifndef ALIGN_UP
#define ALIGN_UP true
#endif
#ifndef ALIGN_DN
#define ALIGN_DN true
#endif
#ifndef ALIGN_MIX
#define ALIGN_MIX true
#endif
#define LAS __attribute__((address_space(3)))
#define GAS __attribute__((address_space(1)))
typedef unsigned short bf16_t;
typedef short bf16x8 __attribute__((ext_vector_type(8)));
typedef short s16x4 __attribute__((ext_vector_type(4)));
typedef float f32x2 __attribute__((ext_vector_type(2)));
typedef float f32x4 __attribute__((ext_vector_type(4)));
typedef float f32x16 __attribute__((ext_vector_type(16)));
typedef unsigned u32x2 __attribute__((ext_vector_type(2)));
typedef unsigned u32x4 __attribute__((ext_vector_type(4)));
typedef int i32x8 __attribute__((ext_vector_type(8)));
typedef int i32x6 __attribute__((ext_vector_type(6)));
typedef unsigned u32x6 __attribute__((ext_vector_type(6)));
typedef int i32x4 __attribute__((ext_vector_type(4)));

constexpr int BATCH = 8, SEQ = 8192, D = 1024, NTOK = BATCH * SEQ;
constexpr int NIN = 4608;
constexpr int NE = 32, TOPK = 4, FE = 1024;
constexpr int NHALF = 1, HTOK = NTOK / NHALF;
constexpr int MAXROWS_H = HTOK * TOPK + NE * 256;
constexpr int MAXTILES_H = MAXROWS_H / 256;
constexpr float DN_ALPHA = 1.189207115002721f;
constexpr int NWAVES = 8, NTHR = 512;

constexpr size_t MiB = 1u << 20;
constexpr size_t WS_CTL = 0, CTL_ZERO_BYTES = 64 * 1024;
constexpr size_t WS_MOD = 1 * MiB;
constexpr size_t WS_ROPE_R = WS_MOD + 256 * 1024;
constexpr size_t WS_ROPE_C = WS_ROPE_R + 32 * 1024;
constexpr size_t WS_M1 = WS_ROPE_C + 16 * 1024;
constexpr size_t WS_HIST = WS_M1 + 32 * 1024;
constexpr size_t WS_ST1 = 1 * MiB + 512 * 1024;
constexpr size_t WS_TILEE = WS_HIST + 32 * 1024;
constexpr size_t WS_ETAB = 2 * MiB;
constexpr size_t WS_WIN = 6 * MiB;
constexpr size_t WS_WF = 15 * MiB;
constexpr size_t WS_WAO = 16 * MiB;
constexpr size_t WS_WOUT = 18 * MiB;
constexpr size_t WS_WGU = 20 * MiB;
constexpr size_t WS_WD = 84 * MiB;
constexpr size_t WS_TOPE = 116 * MiB;
constexpr size_t WS_TOPW = 117 * MiB;
constexpr size_t WS_RANK = 118 * MiB;
constexpr size_t WS_ROWTOK = 119 * MiB;
constexpr size_t WS_ROWDST = 120 * MiB + 512 * 1024;
constexpr size_t WS_ROWW = 122 * MiB;
constexpr size_t WS_U2 = 124 * MiB;
constexpr size_t WS_U = 188 * MiB;
constexpr size_t WS_H = 316 * MiB;
constexpr size_t WS_Q = 444 * MiB;
constexpr size_t WS_K = 572 * MiB;
constexpr size_t WS_V = 604 * MiB;
constexpr size_t WS_G = 636 * MiB;
constexpr size_t WS_KF8 = 892 * MiB;
constexpr size_t WS_VT8 = 908 * MiB;
constexpr size_t WS_K6 = 924 * MiB;
constexpr size_t WS_T = WS_H;
constexpr size_t WS_ACT = 188 * MiB;
constexpr size_t WS_YB = 452 * MiB;
constexpr size_t WS_END = 964 * MiB;
static_assert(!GATE_F8 || P5_FUSED, "fp8 gates are read by the fused branch GEMM only");
static_assert(WS_ROWTOK + (size_t)MAXROWS_H * 4 <= WS_ROWDST && WS_ROWDST + (size_t)MAXROWS_H * 4 <= WS_ROWW && WS_ROWW + (size_t)MAXROWS_H * 4 <= WS_U2, "routing tables");
static_assert(WS_ACT + (size_t)MAXROWS_H * 1024 <= WS_YB && WS_YB + (size_t)HTOK * 4 * 1024 * 2 <= WS_END && WS_G + (size_t)NTOK * 2048 * 2 <= WS_END, "moe overlay");
constexpr int CW_BAR = 1024;

constexpr int RING_BYTES = 131072;
constexpr int LDS_BYTES = 147456;
constexpr int MISC_OFF = LDS_BYTES - 256;

#define LDS_WAIT() asm volatile("s_waitcnt lgkmcnt(0)" ::: "memory")
#define VM_WAIT() asm volatile("s_waitcnt vmcnt(0)" ::: "memory")
typedef __bf16 bf16x2_t __attribute__((ext_vector_type(2)));
__device__ __forceinline__ unsigned cvt_pk_bf16(float lo, float hi) { f32x2 v = {lo, hi}; bf16x2_t b = __builtin_convertvector(v, bf16x2_t); return __builtin_bit_cast(unsigned, b); }
__device__ __forceinline__ float clamp_f8(float v) { return __builtin_amdgcn_fmed3f(v, -448.0f, 448.0f); }
__device__ __forceinline__ unsigned pack4_fp8_nc(float a, float b, float c, float d) { int w = __builtin_amdgcn_cvt_pk_fp8_f32(a, b, 0, false); w = __builtin_amdgcn_cvt_pk_fp8_f32(c, d, w, true); return (unsigned)w; }
__device__ __forceinline__ unsigned pack4_fp8(float a, float b, float c, float d) { int w = __builtin_amdgcn_cvt_pk_fp8_f32(clamp_f8(a), clamp_f8(b), 0, false); w = __builtin_amdgcn_cvt_pk_fp8_f32(clamp_f8(c), clamp_f8(d), w, true); return (unsigned)w; }
__device__ __forceinline__ float bf_lo(unsigned w) { return __uint_as_float(w << 16); }
__device__ __forceinline__ float bf_hi(unsigned w) { return __uint_as_float(w & 0xffff0000u); }
__device__ __forceinline__ float sigmoidf_(float x) { return __builtin_amdgcn_rcpf(1.0f + __builtin_amdgcn_exp2f(-1.4426950408889634f * x)); }
__device__ __forceinline__ int tid_fresh() { int t = threadIdx.x; asm volatile("" : "+v"(t)); return t; }
__device__ __forceinline__ void wave_sum2(float& a, float& b) {
#pragma unroll
    for (int o = 1; o < 64; o <<= 1) { const float ta = __shfl_xor(a, o), tb = __shfl_xor(b, o); a += ta; b += tb; }
}
__device__ __forceinline__ float wave_sum(float v) {
#pragma unroll
    for (int o = 1; o < 64; o <<= 1) v += __shfl_xor(v, o);
    return v;
}

#define XB_TMO      128
#define XB_XCNT(j)  (256  + 64 * (j))
#define XB_XSUB(j)  (1280 + 64 * (j))
#define XB_XGEN(j)  (2304 + 64 * (j))
#define XB_TOP      3328
#define XB_TOPGEN   3392
#define XCD_BAR_WORDS 3456
#define XB_SPIN_CAP (1u << 18)
__device__ __forceinline__ unsigned xb_ld(unsigned* p)              { return __hip_atomic_load(p, __ATOMIC_RELAXED, __HIP_MEMORY_SCOPE_AGENT); }
__device__ __forceinline__ unsigned xb_add(unsigned* p, unsigned v) { return __hip_atomic_fetch_add(p, v, __ATOMIC_RELAXED, __HIP_MEMORY_SCOPE_AGENT); }
__device__ __forceinline__ unsigned xb_xcc_id() { return (unsigned)__builtin_amdgcn_s_getreg((3 << 11) | 20) & 0xFu; }
#define XB_SPIN(cond, bar) do { unsigned _sp = 0; while (cond) { __builtin_amdgcn_s_sleep(1); \
    if ((++_sp & 255u) == 0u) { if (xb_ld(&(bar)[XB_TMO])) break; if (_sp > XB_SPIN_CAP) { atomicAdd(&(bar)[XB_TMO], 1u); break; } } } } while (0)
struct XcdBarrier { unsigned* bar; unsigned x; volatile LAS unsigned* st; };
__device__ __forceinline__ XcdBarrier xcd_barrier_post(unsigned* bar, volatile LAS unsigned* st) {
    XcdBarrier b; b.bar = bar; b.x = xb_xcc_id(); b.st = st;
    if (threadIdx.x == 0) (void)xb_add(&bar[XB_XCNT(b.x)], 1u);
    return b;
}
__device__ __forceinline__ void xcd_barrier_complete(unsigned* bar, unsigned x, unsigned& nloc, unsigned& nx) {
    const unsigned G = gridDim.x * gridDim.y * gridDim.z;
    unsigned sum, cnt, mine, sp = 0u;
    for (;;) {
        sum = 0u; cnt = 0u; mine = 0u;
#pragma unroll
        for (unsigned j = 0; j < 16; ++j) { const unsigned c = xb_ld(&bar[XB_XCNT(j)]); sum += c; cnt += (c > 0u) ? 1u : 0u; mine = (j == x) ? c : mine; }
        if (sum == G) break;
        __builtin_amdgcn_s_sleep(1);
        if ((++sp & 255u) == 0u) { if (xb_ld(&bar[XB_TMO])) break; if (sp > XB_SPIN_CAP) { atomicAdd(&bar[XB_TMO], 1u); break; } }
    }
    nloc = mine > 0u ? mine : 1u; nx = cnt > 0u ? cnt : 1u;
}
__device__ __forceinline__ void xcd_barrier(const XcdBarrier& b) {
    asm volatile("s_waitcnt vmcnt(0)" ::: "memory");
    __syncthreads();
    if (threadIdx.x == 0) {
        unsigned* bar = b.bar;
        __builtin_amdgcn_s_waitcnt(0);
        unsigned nloc = b.st[0], nx = b.st[1];
        if (nloc == 0u) { xcd_barrier_complete(bar, b.x, nloc, nx); b.st[0] = nloc; b.st[1] = nx; }
        const unsigned old = xb_add(&bar[XB_XSUB(b.x)], 1u);
        const unsigned gen = old / nloc;
        if (old + 1u == (gen + 1u) * nloc) {
            __builtin_amdgcn_fence(__ATOMIC_RELEASE, "agent");
            asm volatile("s_waitcnt vmcnt(0)" ::: "memory");
            const unsigned og = xb_add(&bar[XB_TOP], 1u);
            const unsigned tg = og / nx;
            if (og + 1u == (tg + 1u) * nx) xb_add(&bar[XB_TOPGEN], 1u);
            else XB_SPIN(xb_ld(&bar[XB_TOPGEN]) == tg, bar);
            __builtin_amdgcn_fence(__ATOMIC_ACQUIRE, "agent");
            xb_add(&bar[XB_XGEN(b.x)], 1u);
            asm volatile("s_waitcnt vmcnt(0)" ::: "memory");
        } else {
            XB_SPIN(xb_ld(&bar[XB_XGEN(b.x)]) == gen, bar);
            __builtin_amdgcn_fence(__ATOMIC_ACQUIRE, "agent");
            asm volatile("s_waitcnt vmcnt(0)" ::: "memory");
        }
    }
    __syncthreads();
}

namespace pg8 {
constexpr int BM = 256, BK = 64, HALF = 128, HTB = HALF * BK * 2, NXCD = 8, WGM = 8;
__host__ __device__ __forceinline__ int lds_byte(int r, int c) { const int st = (r >> 4) * 2 + (c >> 5), rr = r & 15, cc = c & 31, ob = rr * 64 + cc * 2; return st * 1024 + (ob ^ (((ob >> 9) & 1) << 5)); }
__host__ __device__ __forceinline__ void stage_rc(int b, int& R, int& C) { const int st = b / 1024, sb = b % 1024, swz = sb ^ (((sb >> 9) & 1) << 5); R = (st >> 1) * 16 + swz / 64; C = (st & 1) * 32 + (swz % 64) / 2; }
__host__ __device__ __forceinline__ int perm32(int rho) { const int n = rho >> 4, i = rho & 15; return 8 * (i >> 2) + 4 * n + (i & 3); }

struct Unit { int pm, pn, e; size_t bofs; };
struct Gemm { const bf16_t* A; const bf16_t* Bt; const int* rowtab; int K; };

__device__ __forceinline__ bool tile_order(int i, int G, int c, int nM, int nN, int& pm, int& pn) {
    const int nwg = nM * nN; const long L = (long)i * G + c; if (L >= nwg) return false;
    int wgid = (int)L; { const int q = nwg / NXCD, r = nwg % NXCD, xcd = wgid % NXCD, off = wgid / NXCD; wgid = (xcd < r ? xcd * (q + 1) : r * (q + 1) + (xcd - r) * q) + off; }
    const int nig = WGM * nN, gid = wgid / nig, fm = gid * WGM, gsz = (nM - fm) < WGM ? (nM - fm) : WGM;
    pm = fm + ((wgid % nig) % gsz); pn = (wgid % nig) / gsz; return true;
}
struct DenseOrder {
    int nM, nN, G, c, K;
    __device__ __forceinline__ bool next(int i, Unit& u) const { if (!tile_order(i, G, c, nM, nN, u.pm, u.pn)) return false; u.e = 0; u.bofs = (size_t)u.pn * 256 * K; return true; }
};
struct MoeOrder {
    int nM, nN, G, c, K; const int* tile_e; size_t estride;
    __device__ __forceinline__ bool next(int i, Unit& u) const { if (!tile_order(i, G, c, nM, nN, u.pm, u.pn)) return false;
        u.e = __builtin_amdgcn_readfirstlane(tile_e[u.pm]); u.bofs = (size_t)u.e * estride + (size_t)u.pn * 256 * K; return true; }
};

template <class Epi, class Sched, bool GATHER, bool ALIGN_EPI = true, bool F8 = false>
__device__ __forceinline__ void gemm_phase(LAS unsigned char* lds, const Gemm g, const Sched& S, const Epi& E) {
    const int tid = tid_fresh(), wid = __builtin_amdgcn_readfirstlane(tid >> 6), lane = tid & 63, wr = wid >> 2, wc = wid & 3, fr = lane & 15, fq = lane >> 4;
    const int K = g.K, KB = F8 ? K : 2 * K, nt = KB / 128;
    int Rl[2], Cl[2]; unsigned voffB[2];
#pragma unroll
    for (int i = 0; i < 2; ++i) { int R, C; stage_rc(tid * 16 + i * 8192, R, C); Rl[i] = R;
        { const int jp = C >> 3; Cl[i] = F8 ? (2 * (jp & 3) + (jp >> 2)) * 16 : C * 2; }
        const int Rb = (R & ~31) + perm32(R & 31); voffB[i] = (unsigned)(Rb * KB + Cl[i]); }
    const size_t kstep = (size_t)128;
    const size_t hstep = (size_t)HALF * KB;
    const unsigned ldsw = (unsigned)wid * 1024u;
    const int aoff = lds_byte(wr * 64 + fr, fq * 8), boff = lds_byte(wc * 32 + fr, fq * 8);
#define PG8_SA(b, h) (((b) * 2 + (h)) * HTB)
#define PG8_SB(b, h) ((4 + (b) * 2 + (h)) * HTB)
#define PG8_STAGE(bufoff, gbase, v0, v1) do { \
        __builtin_amdgcn_global_load_lds((const unsigned*)((const char*)(gbase) + (v0)), (LAS unsigned*)(lds + (bufoff) + ldsw), 16, 0, 0); \
        __builtin_amdgcn_global_load_lds((const unsigned*)((const char*)(gbase) + (v1)), (LAS unsigned*)(lds + (bufoff) + ldsw + 8192), 16, 0, 0); } while (0)
#define PG8_LD8(p) __builtin_shufflevector(*(const LAS i32x4*)(p), *(const LAS i32x4*)((p) + 1024), 0, 1, 2, 3, 4, 5, 6, 7)
#define PG8_LDA(dst, b, h) do { _Pragma("unroll") for (int m = 0; m < 4; ++m) dst[m] = PG8_LD8(lds + PG8_SA(b, h) + aoff + m * 2048); } while (0)
#define PG8_LDB(dst, b, h) do { _Pragma("unroll") for (int n = 0; n < 2; ++n) dst[n] = PG8_LD8(lds + PG8_SB(b, h) + boff + n * 2048); } while (0)
#define PG8_LO(x) __builtin_bit_cast(bf16x8, __builtin_shufflevector((x), (x), 0, 1, 2, 3))
#define PG8_HI(x) __builtin_bit_cast(bf16x8, __builtin_shufflevector((x), (x), 4, 5, 6, 7))
#define PG8_MMA(ai, bj, At, Bt) do { __builtin_amdgcn_s_setprio(1); \
        if constexpr (F8) { _Pragma("unroll") for (int m = 0; m < 4; ++m) _Pragma("unroll") for (int n = 0; n < 2; ++n) \
            asm volatile("v_mfma_scale_f32_16x16x128_f8f6f4 %0, %1, %2, %0, %3, %3 op_sel_hi:[0,0,0]" : "+v"(acc[ai][bj][m][n]) : "v"(Bt[n]), "v"(At[m]), "v"(f8scale)); } \
        else { _Pragma("unroll") for (int m = 0; m < 4; ++m) _Pragma("unroll") for (int n = 0; n < 2; ++n) { \
            acc[ai][bj][m][n] = __builtin_amdgcn_mfma_f32_16x16x32_bf16(PG8_LO(Bt[n]), PG8_LO(At[m]), acc[ai][bj][m][n], 0, 0, 0); \
            acc[ai][bj][m][n] = __builtin_amdgcn_mfma_f32_16x16x32_bf16(PG8_HI(Bt[n]), PG8_HI(At[m]), acc[ai][bj][m][n], 0, 0, 0); } } \
        __builtin_amdgcn_s_setprio(0); } while (0)
#define PG8_WAIT_V(n) asm volatile("s_waitcnt vmcnt(" #n ")" ::: "memory")
#define PG8_WAIT_L(n) asm volatile("s_waitcnt lgkmcnt(" #n ")" ::: "memory")
#define PG8_BAR __builtin_amdgcn_s_barrier()
#define PG8_SCHED __builtin_amdgcn_sched_barrier(0)
#define PG8_AOFFS(u, v) do { _Pragma("unroll") for (int h_ = 0; h_ < 2; ++h_) _Pragma("unroll") for (int i_ = 0; i_ < 2; ++i_) { \
        int row_ = (u).pm * BM + h_ * HALF + Rl[i_]; if (GATHER) row_ = g.rowtab[row_]; (v)[h_][i_] = (unsigned)(row_ * KB + Cl[i_]); } } while (0)
    Unit cur, nxt; int ui = 0;
    if (!S.next(0, cur)) return;
    f32x4 acc[2][2][4][2];
#pragma unroll
    for (int a = 0; a < 2; ++a)
#pragma unroll
        for (int b = 0; b < 2; ++b)
#pragma unroll
            for (int m = 0; m < 4; ++m)
#pragma unroll
                for (int n = 0; n < 2; ++n) acc[a][b][m][n] = (f32x4){0.f, 0.f, 0.f, 0.f};
    i32x8 At[4], B0[2], B1[2];
    const int f8scale = 0x7f7f7f7f;
    unsigned cv[2][2], nv[2][2];
    PG8_AOFFS(cur, cv);
    E.unit_begin(cur, lds, wid, lane, 0);
    const char* const Ab = (const char*)g.A;
    const char* cB = (const char*)g.Bt + cur.bofs;
    PG8_STAGE(PG8_SB(0, 0), cB, voffB[0], voffB[1]); PG8_STAGE(PG8_SB(0, 1), cB + hstep, voffB[0], voffB[1]); PG8_STAGE(PG8_SA(0, 0), Ab, cv[0][0], cv[0][1]); PG8_STAGE(PG8_SA(0, 1), Ab, cv[1][0], cv[1][1]);
    if (wr == 1) PG8_BAR;
    PG8_WAIT_V(2); PG8_BAR;
    PG8_STAGE(PG8_SB(1, 0), cB + kstep, voffB[0], voffB[1]); PG8_STAGE(PG8_SA(1, 0), Ab + kstep, cv[0][0], cv[0][1]); PG8_STAGE(PG8_SB(1, 1), cB + hstep + kstep, voffB[0], voffB[1]);
    PG8_WAIT_V(6); PG8_BAR;
    for (;;) {
        const bool has_next = S.next(ui + 1, nxt);
        if (has_next) { PG8_AOFFS(nxt, nv); } else {
#pragma unroll
            for (int h_ = 0; h_ < 2; ++h_)
#pragma unroll
                for (int i_ = 0; i_ < 2; ++i_) nv[h_][i_] = cv[h_][i_]; }
        const char* nB = has_next ? (const char*)g.Bt + nxt.bofs : cB;
#pragma unroll 1
        for (int t = 0; t < nt; t += 2) {
            const bool last = (t == nt - 2);
            const char* a1 = Ab + (size_t)(t + 1) * kstep;
            const char* a2 = last ? Ab : Ab + (size_t)(t + 2) * kstep; const char* b2 = last ? nB : cB + (size_t)(t + 2) * kstep;
            const char* a3 = a2 + kstep; const char* b3 = b2 + kstep;
            const unsigned s00 = last ? nv[0][0] : cv[0][0], s01 = last ? nv[0][1] : cv[0][1], s10 = last ? nv[1][0] : cv[1][0], s11 = last ? nv[1][1] : cv[1][1];
            PG8_LDB(B0, 0, 0); PG8_LDB(B1, 0, 1); PG8_SCHED; PG8_LDA(At, 0, 0); PG8_STAGE(PG8_SA(1, 1), a1, cv[1][0], cv[1][1]);
            PG8_WAIT_V(8); PG8_WAIT_L(0); PG8_BAR; PG8_MMA(0, 0, At, B0); PG8_MMA(0, 1, At, B1); PG8_BAR; PG8_SCHED;
            PG8_LDA(At, 0, 1); PG8_STAGE(PG8_SB(0, 0), b2, voffB[0], voffB[1]); PG8_STAGE(PG8_SB(0, 1), b2 + hstep, voffB[0], voffB[1]); PG8_STAGE(PG8_SA(0, 0), a2, s00, s01);
            PG8_WAIT_V(8); PG8_WAIT_L(0); PG8_BAR; PG8_MMA(1, 0, At, B0); PG8_MMA(1, 1, At, B1); PG8_BAR; PG8_SCHED;
            PG8_LDB(B0, 1, 0); PG8_LDB(B1, 1, 1); PG8_SCHED; PG8_LDA(At, 1, 0); PG8_STAGE(PG8_SA(0, 1), a2, s10, s11);
            PG8_WAIT_V(8); PG8_WAIT_L(0); PG8_BAR; PG8_MMA(0, 0, At, B0); PG8_MMA(0, 1, At, B1); PG8_BAR; PG8_SCHED;
            PG8_LDA(At, 1, 1); PG8_STAGE(PG8_SB(1, 0), b3, voffB[0], voffB[1]); PG8_STAGE(PG8_SB(1, 1), b3 + hstep, voffB[0], voffB[1]); PG8_STAGE(PG8_SA(1, 0), a3, s00, s01);
            PG8_WAIT_V(8); PG8_WAIT_L(0); PG8_BAR; PG8_MMA(1, 0, At, B0); PG8_MMA(1, 1, At, B1); PG8_BAR; PG8_SCHED;
        }
        if (ALIGN_EPI) { if (wr == 0) PG8_BAR; }
        if constexpr (F8) asm volatile("s_nop 15\n\ts_nop 15\n\ts_nop 15" ::: "memory");
        if constexpr (Epi::NEEDS_LDS) E.run(acc, cur, wr, wc, fr, fq, lds, ui); else E(acc, cur, wr, wc, fr, fq);
        if (!has_next) break;
#pragma unroll
        for (int a = 0; a < 2; ++a)
#pragma unroll
            for (int b = 0; b < 2; ++b)
#pragma unroll
                for (int m = 0; m < 4; ++m)
#pragma unroll
                    for (int n = 0; n < 2; ++n) acc[a][b][m][n] = (f32x4){0.f, 0.f, 0.f, 0.f};
        cur = nxt; cB = nB; ++ui;
        E.unit_begin(cur, lds, wid, lane, ui);
#pragma unroll
        for (int h_ = 0; h_ < 2; ++h_)
#pragma unroll
            for (int i_ = 0; i_ < 2; ++i_) cv[h_][i_] = nv[h_][i_];
        if (ALIGN_EPI) { if (wr == 1) PG8_BAR; }
    }
    PG8_WAIT_V(0);
    if (!ALIGN_EPI) { if (wr == 0) PG8_BAR; }
    PG8_BAR;
#undef PG8_SA
#undef PG8_SB
#undef PG8_STAGE
#undef PG8_LDA
#undef PG8_LDB
#undef PG8_MMA
#undef PG8_LO
#undef PG8_HI
#undef PG8_LD8
#undef PG8_WAIT_V
#undef PG8_WAIT_L
#undef PG8_BAR
#undef PG8_SCHED
#undef PG8_AOFFS
}

#define EPI_FOREACH(acc, wr, wc, fr, fq, ...) \
    _Pragma("unroll") for (int ai = 0; ai < 2; ++ai) _Pragma("unroll") for (int m = 0; m < 4; ++m) { const int rt_ = ai * 128 + wr * 64 + m * 16 + fr; \
        _Pragma("unroll") for (int bj = 0; bj < 2; ++bj) { const int ct_ = bj * 128 + wc * 32 + 8 * fq; const f32x4 v0 = acc[ai][bj][m][0], v1 = acc[ai][bj][m][1]; __VA_ARGS__ } }

__device__ __forceinline__ u32x4 pack8(f32x4 a, f32x4 b) { u32x4 w; w.x = cvt_pk_bf16(a[0], a[1]); w.y = cvt_pk_bf16(a[2], a[3]); w.z = cvt_pk_bf16(b[0], b[1]); w.w = cvt_pk_bf16(b[2], b[3]); return w; }
__device__ __forceinline__ void unpack8(u32x4 w, f32x4& a, f32x4& b) { a = (f32x4){bf_lo(w.x), bf_hi(w.x), bf_lo(w.y), bf_hi(w.y)}; b = (f32x4){bf_lo(w.z), bf_hi(w.z), bf_lo(w.w), bf_hi(w.w)}; }
__device__ __forceinline__ void unpack8_f8(u32x2 w, f32x4& a, f32x4& b) { typedef float f32x2_ __attribute__((ext_vector_type(2)));
    const f32x2_ a0 = __builtin_amdgcn_cvt_pk_f32_fp8((int)w.x, false), a1 = __builtin_amdgcn_cvt_pk_f32_fp8((int)w.x, true), b0 = __builtin_amdgcn_cvt_pk_f32_fp8((int)w.y, false), b1 = __builtin_amdgcn_cvt_pk_f32_fp8((int)w.y, true);
    a = (f32x4){a0[0], a0[1], a1[0], a1[1]}; b = (f32x4){b0[0], b0[1], b1[0], b1[1]}; }
__device__ __forceinline__ f32x4 sig4(f32x4 v) { return (f32x4){sigmoidf_(v[0]), sigmoidf_(v[1]), sigmoidf_(v[2]), sigmoidf_(v[3])}; }

#define EPI_NOHOOK static constexpr bool NEEDS_LDS = false; __device__ __forceinline__ void unit_begin(const Unit&, LAS unsigned char*, int, int, int) const {} \
    __device__ __forceinline__ void run(const f32x4 (&)[2][2][4][2], const Unit&, int, int, int, int, LAS unsigned char*, int) const {}
struct EpiInProj { EPI_NOHOOK
    bf16_t *Hb, *Qb, *Kb, *Vb, *Gb; float osc;
    __device__ __forceinline__ void operator()(const f32x4 (&acc)[2][2][4][2], const Unit& u, int wr, int wc, int fr, int fq) const {
        bf16_t* base; int ld, colt; bool sg = false;
        if (u.pn < 4) { base = Hb; ld = 1024; colt = u.pn * 256; }
        else if (u.pn < 8) { base = Qb; ld = 1024; colt = (u.pn - 4) * 256; }
        else if (u.pn == 8) { base = Kb; ld = 256; colt = 0; }
        else if (u.pn == 9) { base = Vb; ld = 256; colt = 0; }
        else { base = Gb; ld = 2048; colt = (u.pn - 10) * 256; sg = true; }
        EPI_FOREACH(acc, wr, wc, fr, fq, {
            f32x4 a = v0 * osc, b = v1 * osc; if (sg) { a = sig4(a); b = sig4(b); }
            if (GATE_F8 && sg) { const float fl = 0.001953125f;
                *(u32x2*)((unsigned char*)base + (size_t)(u.pm * 256 + rt_) * 2048 + colt + ct_) = (u32x2){pack4_fp8_nc(fmaxf(a[0], fl), fmaxf(a[1], fl), fmaxf(a[2], fl), fmaxf(a[3], fl)), pack4_fp8_nc(fmaxf(b[0], fl), fmaxf(b[1], fl), fmaxf(b[2], fl), fmaxf(b[3], fl))}; }
            else *(u32x4*)(base + (size_t)(u.pm * 256 + rt_) * ld + colt + ct_) = pack8(a, b); })
    }
};
struct EpiGateF { EPI_NOHOOK
    const bf16_t* Gb; bf16_t* tmp;
    __device__ __forceinline__ void operator()(const f32x4 (&acc)[2][2][4][2], const Unit& u, int wr, int wc, int fr, int fq) const {
        EPI_FOREACH(acc, wr, wc, fr, fq, {
            const size_t row = (size_t)(u.pm * 256 + rt_); const int col = u.pn * 256 + ct_;
            f32x4 ga, gb; unpack8(*(const u32x4*)(Gb + row * 2048 + col), ga, gb);
            *(u32x4*)(tmp + row * 1024 + col) = pack8(ga * v0, gb * v1); })
    }
};
struct EpiGateA { EPI_NOHOOK
    const bf16_t* Gb; const bf16_t* tmp; bf16_t* Mb;
    __device__ __forceinline__ void operator()(const f32x4 (&acc)[2][2][4][2], const Unit& u, int wr, int wc, int fr, int fq) const {
        EPI_FOREACH(acc, wr, wc, fr, fq, {
            const size_t row = (size_t)(u.pm * 256 + rt_); const int col = u.pn * 256 + ct_;
            f32x4 ga, gb; unpack8(*(const u32x4*)(Gb + row * 2048 + 1024 + col), ga, gb);
            f32x4 t0, t1; unpack8(*(const u32x4*)(tmp + row * 1024 + col), t0, t1);
            *(u32x4*)(Mb + row * 1024 + col) = pack8(t0 + ga * v0, t1 + gb * v1); })
    }
};
struct EpiOut { EPI_NOHOOK
    const float* x; const float* mod; float* pre; float osc;
    __device__ __forceinline__ void operator()(const f32x4 (&acc)[2][2][4][2], const Unit& u, int wr, int wc, int fr, int fq) const {
        const float* g1 = mod + (size_t)((u.pm * 256) / SEQ) * 6144 + 2 * 1024 + u.pn * 256 + wc * 32 + 8 * fq;
        f32x4 gA[2], gB[2];
#pragma unroll
        for (int bj = 0; bj < 2; ++bj) { gA[bj] = *(const f32x4*)(g1 + bj * 128) * osc; gB[bj] = *(const f32x4*)(g1 + bj * 128 + 4) * osc; }
#pragma unroll
        for (int ai = 0; ai < 2; ++ai) { f32x4 xa[4][2], xb[4][2];
#pragma unroll
            for (int m = 0; m < 4; ++m) { const size_t row = (size_t)(u.pm * 256 + ai * 128 + wr * 64 + m * 16 + fr);
#pragma unroll
                for (int bj = 0; bj < 2; ++bj) { const int col = u.pn * 256 + bj * 128 + wc * 32 + 8 * fq; xa[m][bj] = *(const f32x4*)(x + row * 1024 + col); xb[m][bj] = *(const f32x4*)(x + row * 1024 + col + 4); } }
            __builtin_amdgcn_sched_barrier(0);
#pragma unroll
            for (int m = 0; m < 4; ++m) { const size_t row = (size_t)(u.pm * 256 + ai * 128 + wr * 64 + m * 16 + fr);
#pragma unroll
                for (int bj = 0; bj < 2; ++bj) { const int col = u.pn * 256 + bj * 128 + wc * 32 + 8 * fq;
                    *(u32x4*)((bf16_t*)(pre + row * 1024) + col) = pack8(xa[m][bj] * DN_ALPHA + gA[bj] * acc[ai][bj][m][0], xb[m][bj] * DN_ALPHA + gB[bj] * acc[ai][bj][m][1]); } }
            __builtin_amdgcn_sched_barrier(0); }
    }
};
struct EpiSwiglu { EPI_NOHOOK
    const float* bgu; unsigned char* act;
    __device__ __forceinline__ void operator()(const f32x4 (&acc)[2][2][4][2], const Unit& u, int wr, int wc, int fr, int fq) const {
        const float* bg = bgu + (size_t)u.e * 2048 + u.pn * 128 + wc * 32 + 8 * fq; const float* bu = bg + 1024;
        const f32x4 bg0 = *(const f32x4*)bg, bg1 = *(const f32x4*)(bg + 4), bu0 = *(const f32x4*)bu, bu1 = *(const f32x4*)(bu + 4);
#pragma unroll
        for (int ai = 0; ai < 2; ++ai)
#pragma unroll
            for (int m = 0; m < 4; ++m) {
                const size_t row = (size_t)(u.pm * 256 + ai * 128 + wr * 64 + m * 16 + fr);
                f32x4 r[2];
#pragma unroll
                for (int n = 0; n < 2; ++n) {
                    const f32x4 gt = acc[ai][0][m][n] * 0.03125f + (n ? bg1 : bg0), up = acc[ai][1][m][n] * 0.03125f + (n ? bu1 : bu0);
#pragma unroll
                    for (int j = 0; j < 4; ++j) { const float gc = fminf(gt[j], 7.0f), uc = fminf(fmaxf(up[j], -7.0f), 7.0f);
                        r[n][j] = fmaf(uc, gc, gc) * __builtin_amdgcn_rcpf(1.0f + __builtin_amdgcn_exp2f(-2.4554669595930156f * gc)); }
                }
                *(u32x2*)(act + row * 1024 + u.pn * 128 + wc * 32 + 8 * fq) = (u32x2){pack4_fp8_nc(r[0][0], r[0][1], r[0][2], r[0][3]), pack4_fp8_nc(r[1][0], r[1][1], r[1][2], r[1][3])};
            }
    }
};
struct EpiDown {
    const float* bd; const int* rowdst; const float* roww; bf16_t* yb;
    static constexpr int TAB = 131072;
    __device__ __forceinline__ void unit_begin(const Unit& u, LAS unsigned char* lds, int wid, int lane, int ui) const {
        if (wid == 0) { const unsigned base = (unsigned)(uintptr_t)lds + TAB + (ui & 1) * 2048;
            __builtin_amdgcn_global_load_lds((const unsigned*)(rowdst + u.pm * 256 + lane * 4), (LAS unsigned*)(base), 16, 0, 0);
            __builtin_amdgcn_global_load_lds((const unsigned*)(roww + u.pm * 256 + lane * 4), (LAS unsigned*)(base + 1024), 16, 0, 0); }
    }
    __device__ __forceinline__ void run(const f32x4 (&acc)[2][2][4][2], const Unit& u, int wr, int wc, int fr, int fq, LAS unsigned char* lds, int ui) const {
        const float* bb = bd + (size_t)u.e * 1024 + u.pn * 256 + wc * 32 + 8 * fq;
        const LAS int* tdst = (const LAS int*)(lds + TAB + (ui & 1) * 2048); const LAS float* tw = (const LAS float*)(lds + TAB + (ui & 1) * 2048 + 1024);
        f32x4 b0[2], b1[2];
#pragma unroll
        for (int bj = 0; bj < 2; ++bj) { b0[bj] = *(const f32x4*)(bb + bj * 128); b1[bj] = *(const f32x4*)(bb + bj * 128 + 4); }
        int dsts[2][4]; float wts[2][4];
#pragma unroll
        for (int ai = 0; ai < 2; ++ai)
#pragma unroll
            for (int m = 0; m < 4; ++m) { const int rl = ai * 128 + wr * 64 + m * 16 + fr; dsts[ai][m] = tdst[rl]; wts[ai][m] = tw[rl]; }
        __builtin_amdgcn_s_waitcnt(0x0070); __builtin_amdgcn_sched_barrier(0);
#pragma unroll
        for (int ai = 0; ai < 2; ++ai)
#pragma unroll
            for (int m = 0; m < 4; ++m) {
                const int dst = dsts[ai][m]; const float w = wts[ai][m];
                if (dst >= 0) {
#pragma unroll
                    for (int bj = 0; bj < 2; ++bj)
                        if (YB_F8) { const float w8 = w * 8.0f; const f32x4 ya = (acc[ai][bj][m][0] * 0.03125f + b0[bj]) * w8, yc = (acc[ai][bj][m][1] * 0.03125f + b1[bj]) * w8;
                            *(u32x2*)((unsigned char*)yb + (size_t)dst * 1024 + u.pn * 256 + bj * 128 + wc * 32 + 8 * fq) = (u32x2){pack4_fp8(ya[0], ya[1], ya[2], ya[3]), pack4_fp8(yc[0], yc[1], yc[2], yc[3])}; }
                        else *(u32x4*)(yb + (size_t)dst * 1024 + u.pn * 256 + bj * 128 + wc * 32 + 8 * fq) = pack8((acc[ai][bj][m][0] * 0.03125f + b0[bj]) * w, (acc[ai][bj][m][1] * 0.03125f + b1[bj]) * w);
                }
            }
    }
    static constexpr bool NEEDS_LDS = true;
    __device__ __forceinline__ void operator()(const f32x4 (&)[2][2][4][2], const Unit&, int, int, int, int) const {}
};

__device__ __forceinline__ void gemm_p5_fused(LAS unsigned char* lds, const bf16_t* Yb, const bf16_t* Wft, const bf16_t* Ob, const bf16_t* Waot, const bf16_t* Gb, bf16_t* Mb, int G, int c) {
    const int tid = tid_fresh(), wid = __builtin_amdgcn_readfirstlane(tid >> 6), lane = tid & 63, wr = wid >> 2, wc = wid & 3, fr = lane & 15, fq = lane >> 4;
    constexpr int KB0 = MIX_F8 ? 512 : 1024, KB1 = MIX_F8 ? 1024 : 2048, NT0 = KB0 / 128, NT1 = KB1 / 128;
    int Rl[2], Cl[2], Rb[2];
#pragma unroll
    for (int i = 0; i < 2; ++i) { int R, C; stage_rc(tid * 16 + i * 8192, R, C); Rl[i] = R; { const int jp = C >> 3; Cl[i] = MIX_F8 ? (2 * (jp & 3) + (jp >> 2)) * 16 : C * 2; } Rb[i] = (R & ~31) + perm32(R & 31); }
    const int f8scale = 0x7f7f7f7f;
#define P5_AO(pm_, KB_, h_, i_) ((unsigned)((((pm_) * BM + (h_) * HALF + Rl[i_]) * (KB_)) + Cl[i_]))
#define P5_BO(KB_, i_) ((unsigned)(Rb[i_] * (KB_) + Cl[i_]))
    const unsigned ldsw = (unsigned)wid * 1024u;
    const int aoff = lds_byte(wr * 64 + fr, fq * 8), boff = lds_byte(wc * 32 + fr, fq * 8);
#define PG8_SA(b, h) (((b) * 2 + (h)) * HTB)
#define PG8_SB(b, h) ((4 + (b) * 2 + (h)) * HTB)
#define PG8_STAGE(bufoff, gbase, v0, v1) do { \
        __builtin_amdgcn_global_load_lds((const unsigned*)((const char*)(gbase) + (v0)), (LAS unsigned*)(lds + (bufoff) + ldsw), 16, 0, 0); \
        __builtin_amdgcn_global_load_lds((const unsigned*)((const char*)(gbase) + (v1)), (LAS unsigned*)(lds + (bufoff) + ldsw + 8192), 16, 0, 0); } while (0)
#define PG8_LD8(p) __builtin_shufflevector(*(const LAS i32x4*)(p), *(const LAS i32x4*)((p) + 1024), 0, 1, 2, 3, 4, 5, 6, 7)
#define PG8_LDA(dst, b, h) do { _Pragma("unroll") for (int m = 0; m < 4; ++m) dst[m] = PG8_LD8(lds + PG8_SA(b, h) + aoff + m * 2048); } while (0)
#define PG8_LDB(dst, b, h) do { _Pragma("unroll") for (int n = 0; n < 2; ++n) dst[n] = PG8_LD8(lds + PG8_SB(b, h) + boff + n * 2048); } while (0)
#define PG8_LO(x) __builtin_bit_cast(bf16x8, __builtin_shufflevector((x), (x), 0, 1, 2, 3))
#define PG8_HI(x) __builtin_bit_cast(bf16x8, __builtin_shufflevector((x), (x), 4, 5, 6, 7))
#define PG8_MMA(ai, bj, At, Bt) do { __builtin_amdgcn_s_setprio(1); _Pragma("unroll") for (int m = 0; m < 4; ++m) _Pragma("unroll") for (int n = 0; n < 2; ++n) { \
            if constexpr (MIX_F8 != 0) { asm volatile("v_mfma_scale_f32_16x16x128_f8f6f4 %0, %1, %2, %0, %3, %3 op_sel_hi:[0,0,0]" : "+v"(acc[ai][bj][m][n]) : "v"(Bt[n]), "v"(At[m]), "v"(f8scale)); } else { \
            acc[ai][bj][m][n] = __builtin_amdgcn_mfma_f32_16x16x32_bf16(PG8_LO(Bt[n]), PG8_LO(At[m]), acc[ai][bj][m][n], 0, 0, 0); \
            acc[ai][bj][m][n] = __builtin_amdgcn_mfma_f32_16x16x32_bf16(PG8_HI(Bt[n]), PG8_HI(At[m]), acc[ai][bj][m][n], 0, 0, 0); } } \
        __builtin_amdgcn_s_setprio(0); } while (0)
#define PG8_WAIT_V(n) asm volatile("s_waitcnt vmcnt(" #n ")" ::: "memory")
#define PG8_WAIT_L(n) asm volatile("s_waitcnt lgkmcnt(" #n ")" ::: "memory")
#define PG8_BAR __builtin_amdgcn_s_barrier()
#define PG8_SCHED __builtin_amdgcn_sched_barrier(0)
#define P5_KLOOP(NT, cA, cpm, cKB, cB, nA, npm_, nKB, nB) do { _Pragma("unroll 1") for (int t = 0; t < (NT); t += 2) { \
            const bool last = (t == (NT) - 2); \
            const char* a1 = (cA) + (size_t)(t + 1) * 128; \
            const char* a2 = last ? (nA) : (cA) + (size_t)(t + 2) * 128; const char* b2 = last ? (nB) : (cB) + (size_t)(t + 2) * 128; \
            const char* a3 = a2 + 128; const char* b3 = b2 + 128; const size_t hs2 = (size_t)HALF * (last ? (nKB) : (cKB)); \
            const int spm = last ? (npm_) : (cpm), sKB = last ? (nKB) : (cKB); \
            PG8_LDB(B0, 0, 0); PG8_LDB(B1, 0, 1); PG8_SCHED; PG8_LDA(At, 0, 0); PG8_STAGE(PG8_SA(1, 1), a1, P5_AO(cpm, cKB, 1, 0), P5_AO(cpm, cKB, 1, 1)); \
            PG8_WAIT_V(8); PG8_WAIT_L(0); PG8_BAR; PG8_MMA(0, 0, At, B0); PG8_MMA(0, 1, At, B1); PG8_BAR; PG8_SCHED; \
            PG8_LDA(At, 0, 1); PG8_STAGE(PG8_SB(0, 0), b2, P5_BO(sKB, 0), P5_BO(sKB, 1)); PG8_STAGE(PG8_SB(0, 1), b2 + hs2, P5_BO(sKB, 0), P5_BO(sKB, 1)); PG8_STAGE(PG8_SA(0, 0), a2, P5_AO(spm, sKB, 0, 0), P5_AO(spm, sKB, 0, 1)); \
            PG8_WAIT_V(8); PG8_WAIT_L(0); PG8_BAR; PG8_MMA(1, 0, At, B0); PG8_MMA(1, 1, At, B1); PG8_BAR; PG8_SCHED; \
            PG8_LDB(B0, 1, 0); PG8_LDB(B1, 1, 1); PG8_SCHED; PG8_LDA(At, 1, 0); PG8_STAGE(PG8_SA(0, 1), a2, P5_AO(spm, sKB, 1, 0), P5_AO(spm, sKB, 1, 1)); \
            PG8_WAIT_V(8); PG8_WAIT_L(0); PG8_BAR; PG8_MMA(0, 0, At, B0); PG8_MMA(0, 1, At, B1); PG8_BAR; PG8_SCHED; \
            PG8_LDA(At, 1, 1); PG8_STAGE(PG8_SB(1, 0), b3, P5_BO(sKB, 0), P5_BO(sKB, 1)); PG8_STAGE(PG8_SB(1, 1), b3 + hs2, P5_BO(sKB, 0), P5_BO(sKB, 1)); PG8_STAGE(PG8_SA(1, 0), a3, P5_AO(spm, sKB, 0, 0), P5_AO(spm, sKB, 0, 1)); \
            PG8_WAIT_V(8); PG8_WAIT_L(0); PG8_BAR; PG8_MMA(1, 0, At, B0); PG8_MMA(1, 1, At, B1); PG8_BAR; PG8_SCHED; } } while (0)
    int pm, pn, npm, npn, ti = 0;
    if (!tile_order(0, G, c, NTOK / 256, 4, pm, pn)) return;
    f32x4 acc[2][2][4][2];
#pragma unroll
    for (int a = 0; a < 2; ++a)
#pragma unroll
        for (int b = 0; b < 2; ++b)
#pragma unroll
            for (int m = 0; m < 4; ++m)
#pragma unroll
                for (int n = 0; n < 2; ++n) acc[a][b][m][n] = (f32x4){0.f, 0.f, 0.f, 0.f};
    i32x8 At[4], B0[2], B1[2];
    const char* const Y_ = (const char*)Yb; const char* const O_ = (const char*)Ob;
    const char* cB0 = (const char*)Wft + (size_t)pn * 256 * KB0; const char* cB1 = (const char*)Waot + (size_t)pn * 256 * KB1;
    constexpr size_t HS0 = (size_t)HALF * KB0;
    PG8_STAGE(PG8_SB(0, 0), cB0, P5_BO(KB0, 0), P5_BO(KB0, 1)); PG8_STAGE(PG8_SB(0, 1), cB0 + HS0, P5_BO(KB0, 0), P5_BO(KB0, 1)); PG8_STAGE(PG8_SA(0, 0), Y_, P5_AO(pm, KB0, 0, 0), P5_AO(pm, KB0, 0, 1)); PG8_STAGE(PG8_SA(0, 1), Y_, P5_AO(pm, KB0, 1, 0), P5_AO(pm, KB0, 1, 1));
    if (wr == 1) PG8_BAR;
    PG8_WAIT_V(2); PG8_BAR;
    PG8_STAGE(PG8_SB(1, 0), cB0 + 128, P5_BO(KB0, 0), P5_BO(KB0, 1)); PG8_STAGE(PG8_SA(1, 0), Y_ + 128, P5_AO(pm, KB0, 0, 0), P5_AO(pm, KB0, 0, 1)); PG8_STAGE(PG8_SB(1, 1), cB0 + HS0 + 128, P5_BO(KB0, 0), P5_BO(KB0, 1));
    PG8_WAIT_V(6); PG8_BAR;
    for (;;) {
        const bool has_next = tile_order(ti + 1, G, c, NTOK / 256, 4, npm, npn);
        if (!has_next) { npm = pm; npn = pn; }
        const char* nB0 = (const char*)Wft + (size_t)npn * 256 * KB0;
        P5_KLOOP(NT0, Y_, pm, KB0, cB0, O_, pm, KB1, cB1);
        if (wr == 0) PG8_BAR;
        asm volatile("s_nop 15\n\ts_nop 15" ::: "memory");
        {
#pragma unroll
            for (int ai = 0; ai < 2; ++ai) { u32x4 fw[4][2], gw[4][2];
#pragma unroll
                for (int m = 0; m < 4; ++m) { const size_t row = (size_t)(pm * 256 + ai * 128 + wr * 64 + m * 16 + fr);
#pragma unroll
                    for (int bj = 0; bj < 2; ++bj) { const int col = pn * 256 + bj * 128 + wc * 32 + 8 * fq; if (GATE_F8) { const u32x2 f8_ = *(const u32x2*)((const unsigned char*)Gb + row * 2048 + col), g8_ = *(const u32x2*)((const unsigned char*)Gb + row * 2048 + 1024 + col); fw[m][bj] = (u32x4){f8_.x, f8_.y, 0u, 0u}; gw[m][bj] = (u32x4){g8_.x, g8_.y, 0u, 0u}; }
                        else { fw[m][bj] = *(const u32x4*)(Gb + row * 2048 + col); gw[m][bj] = *(const u32x4*)(Gb + row * 2048 + 1024 + col); } } }
                PG8_SCHED;
#pragma unroll
                for (int m = 0; m < 4; ++m) {
#pragma unroll
                    for (int bj = 0; bj < 2; ++bj) { f32x4 f0, f1, g0, g1;
                        if (GATE_F8) { unpack8_f8((u32x2){fw[m][bj].x, fw[m][bj].y}, f0, f1); unpack8_f8((u32x2){gw[m][bj].x, gw[m][bj].y}, g0, g1); } else { unpack8(fw[m][bj], f0, f1); unpack8(gw[m][bj], g0, g1); }
#pragma unroll
                        for (int j = 0; j < 4; ++j) { const float r0 = (MIX_F8 ? 16.0f : 1.0f) * f0[j] * __builtin_amdgcn_rcpf(g0[j]), r1 = (MIX_F8 ? 16.0f : 1.0f) * f1[j] * __builtin_amdgcn_rcpf(g1[j]);
                            asm volatile("v_mul_f32 %0, %0, %1" : "+v"(acc[ai][bj][m][0][j]) : "v"(r0)); asm volatile("v_mul_f32 %0, %0, %1" : "+v"(acc[ai][bj][m][1][j]) : "v"(r1)); } }
                    PG8_SCHED; } }
        }
        if (wr == 1) PG8_BAR;
        P5_KLOOP(NT1, O_, pm, KB1, cB1, Y_, npm, KB0, nB0);
        if (wr == 0) PG8_BAR;
        {
            int fr2 = fr; asm volatile("" : "+v"(fr2));
#pragma unroll
            for (int ai = 0; ai < 2; ++ai) { u32x4 gw[4][2];
#pragma unroll
                for (int m = 0; m < 4; ++m) { const size_t row = (size_t)(pm * 256 + ai * 128 + wr * 64 + m * 16 + fr2);
#pragma unroll
                    for (int bj = 0; bj < 2; ++bj) { if (GATE_F8) { const u32x2 g8_ = *(const u32x2*)((const unsigned char*)Gb + row * 2048 + 1024 + pn * 256 + bj * 128 + wc * 32 + 8 * fq); gw[m][bj] = (u32x4){g8_.x, g8_.y, 0u, 0u}; }
                        else gw[m][bj] = *(const u32x4*)(Gb + row * 2048 + 1024 + pn * 256 + bj * 128 + wc * 32 + 8 * fq); } }
                PG8_SCHED;
#pragma unroll
                for (int m = 0; m < 4; ++m) { const size_t row = (size_t)(pm * 256 + ai * 128 + wr * 64 + m * 16 + fr2);
#pragma unroll
                    for (int bj = 0; bj < 2; ++bj) { const int col = pn * 256 + bj * 128 + wc * 32 + 8 * fq;
                        f32x4 g0, g1; if (GATE_F8) unpack8_f8((u32x2){gw[m][bj].x, gw[m][bj].y}, g0, g1); else unpack8(gw[m][bj], g0, g1);
                        if (MIX_F8) { const f32x4 a0 = g0 * acc[ai][bj][m][0] * (1.0f / 256.0f), a1 = g1 * acc[ai][bj][m][1] * (1.0f / 256.0f);
                            *(u32x2*)((unsigned char*)Mb + row * 1024 + col) = (u32x2){pack4_fp8(a0[0], a0[1], a0[2], a0[3]), pack4_fp8(a1[0], a1[1], a1[2], a1[3])}; }
                        else *(u32x4*)(Mb + row * 1024 + col) = pack8(g0 * acc[ai][bj][m][0], g1 * acc[ai][bj][m][1]); } }
                PG8_SCHED; }
        }
        if (!has_next) break;
#pragma unroll
        for (int a = 0; a < 2; ++a)
#pragma unroll
            for (int b = 0; b < 2; ++b)
#pragma unroll
                for (int m = 0; m < 4; ++m)
#pragma unroll
                    for (int n = 0; n < 2; ++n) acc[a][b][m][n] = (f32x4){0.f, 0.f, 0.f, 0.f};
        pm = npm; pn = npn; ++ti; cB0 = nB0; cB1 = (const char*)Waot + (size_t)pn * 256 * KB1;
        if (wr == 1) PG8_BAR;
    }
    PG8_WAIT_V(0);
    PG8_BAR;
#undef PG8_SA
#undef PG8_SB
#undef PG8_STAGE
#undef PG8_LDA
#undef PG8_LDB
#undef PG8_MMA
#undef PG8_LO
#undef PG8_HI
#undef PG8_LD8
#undef PG8_WAIT_V
#undef PG8_WAIT_L
#undef PG8_BAR
#undef PG8_SCHED
#undef P5_KLOOP
#undef P5_AO
#undef P5_BO
}
}

#ifndef ATT_SG
#define ATT_SG 1
#endif
#ifndef ATT_DMA
#define ATT_DMA 1
#endif
#ifndef ATT_QK8
#define ATT_QK8 1
#endif
#ifndef ATT_PV8
#define ATT_PV8 1
#ifndef ATT_QK6
#define ATT_QK6 1
#endif
#ifndef ATT_PV6
#define ATT_PV6 1
#endif
#endif
#ifndef ATT_SCVT
#define ATT_SCVT 1
#endif
#ifndef ATT_PHASED
#define ATT_PHASED 0
#endif
#ifndef ATT_SDEPTH_FIXED
#define ATT_SDEPTH_FIXED 1
#endif
namespace att {
constexpr int DH = 128, NW = 8, QBLK = 32, KVBLK = 64;
constexpr float SCALE = 0.088388347648318440f;
constexpr float THR = 8.f;
constexpr int LDQ = 1024, LDK = 256;
constexpr size_t SHM_V = KVBLK * DH * 2, SHM_K = KVBLK * DH * 2, SHM_ATTN = 2 * SHM_V + 2 * SHM_K + NW * 64 * 4;
#define KSWZ(row, colB) ((row) * 256 + ((colB) ^ (((row) & 7) << 4)))
#define SBAR() __builtin_amdgcn_sched_barrier(0)
__device__ __forceinline__ int crow(int r, int hi) { return (r & 3) + 8 * (r >> 2) + 4 * hi; }
template <bool FIXED>
__device__ __forceinline__ void partialSM(f32x16& p0, f32x16& p1, float& m_reg, float& mn, float& alpha) {
  if constexpr (FIXED) { alpha = 1.f; mn = 0.f; }
  else {
  constexpr float THR2 = THR * 1.4426950408889634f;
  float pmax = p0[0]; for (int r = 1; r < 16; ++r) pmax = fmaxf(pmax, p0[r]); for (int r = 0; r < 16; ++r) pmax = fmaxf(pmax, p1[r]);
  { auto rr = __builtin_amdgcn_permlane32_swap(__float_as_uint(pmax), __float_as_uint(pmax), false, false);
    pmax = fmaxf(__uint_as_float(rr[0]), __uint_as_float(rr[1])); }
  if (__builtin_expect(__all(pmax - m_reg <= THR2), 1)) { mn = m_reg; alpha = 1.f; }
  else { mn = fmaxf(m_reg, pmax); alpha = __builtin_amdgcn_exp2f(m_reg - mn); m_reg = mn; }
  for (int r = 0; r < 16; ++r) p0[r] = p0[r] - mn; for (int r = 0; r < 16; ++r) p1[r] = p1[r] - mn; }
  for (int r = 0; r < 16; ++r) p0[r] = __builtin_amdgcn_exp2f(p0[r]);
}
__device__ __forceinline__ void finishSM(f32x16& p0, f32x16& p1, float alpha, float& l_reg, bf16x8& pa0, bf16x8& pa1, bf16x8& pa2, bf16x8& pa3) {
  for (int r = 0; r < 16; ++r) p1[r] = __builtin_amdgcn_exp2f(p1[r]);
  float ps = 0; for (int r = 0; r < 16; ++r) ps += p0[r]; for (int r = 0; r < 16; ++r) ps += p1[r];
  { auto rr = __builtin_amdgcn_permlane32_swap(__float_as_uint(ps), __float_as_uint(ps), false, false);
    ps = __uint_as_float(rr[0]) + __uint_as_float(rr[1]); }
  l_reg = l_reg * alpha + ps;
#define PK4(P, BASE, OUT) do { unsigned a0 = cvt_pk_bf16(P[BASE + 0], P[BASE + 1]), a1 = cvt_pk_bf16(P[BASE + 2], P[BASE + 3]);   \
    unsigned b0 = cvt_pk_bf16(P[BASE + 4], P[BASE + 5]), b1 = cvt_pk_bf16(P[BASE + 6], P[BASE + 7]);                              \
    auto r0 = __builtin_amdgcn_permlane32_swap(a0, b0, false, false); auto r1 = __builtin_amdgcn_permlane32_swap(a1, b1, false, false); \
    u32x4 w = {r0[0], r1[0], r0[1], r1[1]}; OUT = *reinterpret_cast<bf16x8*>(&w); } while (0)
  PK4(p0, 0, pa0); PK4(p0, 8, pa1); PK4(p1, 0, pa2); PK4(p1, 8, pa3);
#undef PK4
}
__device__ __forceinline__ void qkt(f32x16& p0, f32x16& p1, const bf16_t* Ks, const bf16x8* qr, int r32, int hi) {
  p0 = f32x16{}; p1 = f32x16{};
  for (int d0 = 0; d0 < 8; ++d0) { int cb = (d0 * 16 + hi * 8) * 2;
    bf16x8 b0 = *reinterpret_cast<const bf16x8*>((const char*)Ks + KSWZ(r32, cb));
    bf16x8 b1 = *reinterpret_cast<const bf16x8*>((const char*)Ks + KSWZ(32 + r32, cb));
    p0 = __builtin_amdgcn_mfma_f32_32x32x16_bf16(b0, qr[d0], p0, 0, 0, 0);
    p1 = __builtin_amdgcn_mfma_f32_32x32x16_bf16(b1, qr[d0], p1, 0, 0, 0); }
}
__device__ __forceinline__ int v_st(int k, int c) { const int kk = (k & ~0xC) | ((k & 4) << 1) | ((k & 8) >> 1); return ((kk >> 3) * 4 + (c >> 5)) * 512 + ((kk & 7) * 32 + (c & 31)) * 2; }
__device__ __forceinline__ int v_rd_base(int lane) { return ((lane & 3) << 3) | (((lane >> 2) & 3) << 6) | (((lane >> 4) & 1) << 5) | (((lane >> 5) & 1) << 8); }
constexpr int v_rd_off(int d0, int ks, int half) { return d0 * 512 + ks * 4096 + half * 2048; }
template <int OFF> __device__ __forceinline__ s16x4 tr_read(int vb) {
  s16x4 r; asm volatile("ds_read_b64_tr_b16 %0, %1 offset:%2" : "=&v"(r) : "v"(vb), "i"(OFF) : "memory"); return r;
}
template <int D0> __device__ __forceinline__ void pv_one(f32x16& od, int vb, bf16x8 pa0, bf16x8 pa1, bf16x8 pa2, bf16x8 pa3) {
  const s16x4 l0 = tr_read<v_rd_off(D0, 0, 0)>(vb), h0 = tr_read<v_rd_off(D0, 0, 1)>(vb), l1 = tr_read<v_rd_off(D0, 1, 0)>(vb), h1 = tr_read<v_rd_off(D0, 1, 1)>(vb);
  const s16x4 l2 = tr_read<v_rd_off(D0, 2, 0)>(vb), h2 = tr_read<v_rd_off(D0, 2, 1)>(vb), l3 = tr_read<v_rd_off(D0, 3, 0)>(vb), h3 = tr_read<v_rd_off(D0, 3, 1)>(vb);
  asm volatile("s_waitcnt lgkmcnt(0)" ::: "memory"); SBAR();
#define PK(L, H) (bf16x8){L[0], L[1], L[2], L[3], H[0], H[1], H[2], H[3]}
  od = __builtin_amdgcn_mfma_f32_32x32x16_bf16(pa0, PK(l0, h0), od, 0, 0, 0);
  od = __builtin_amdgcn_mfma_f32_32x32x16_bf16(pa1, PK(l1, h1), od, 0, 0, 0);
  od = __builtin_amdgcn_mfma_f32_32x32x16_bf16(pa2, PK(l2, h2), od, 0, 0, 0);
  od = __builtin_amdgcn_mfma_f32_32x32x16_bf16(pa3, PK(l3, h3), od, 0, 0, 0);
#undef PK
}
__device__ __forceinline__ void pv_d0(f32x16* o, int vb, bf16x8 pa0, bf16x8 pa1, bf16x8 pa2, bf16x8 pa3) {
  pv_one<0>(o[0], vb, pa0, pa1, pa2, pa3); pv_one<1>(o[1], vb, pa0, pa1, pa2, pa3); pv_one<2>(o[2], vb, pa0, pa1, pa2, pa3); pv_one<3>(o[3], vb, pa0, pa1, pa2, pa3);
}
__device__ __forceinline__ void pv_d0_exp(f32x16* o, int vb, bf16x8 pa0, bf16x8 pa1, bf16x8 pa2, bf16x8 pa3, f32x16& pn) {
  pv_one<0>(o[0], vb, pa0, pa1, pa2, pa3); for (int r = 0; r < 4; ++r) pn[r] = __builtin_amdgcn_exp2f(pn[r]);
  pv_one<1>(o[1], vb, pa0, pa1, pa2, pa3); for (int r = 4; r < 8; ++r) pn[r] = __builtin_amdgcn_exp2f(pn[r]);
  pv_one<2>(o[2], vb, pa0, pa1, pa2, pa3); for (int r = 8; r < 12; ++r) pn[r] = __builtin_amdgcn_exp2f(pn[r]);
  pv_one<3>(o[3], vb, pa0, pa1, pa2, pa3); for (int r = 12; r < 16; ++r) pn[r] = __builtin_amdgcn_exp2f(pn[r]);
  SBAR();
}

#define TR8(S, D0, vb) const s16x4 S##l0 = tr_read<v_rd_off(D0, 0, 0)>(vb), S##h0 = tr_read<v_rd_off(D0, 0, 1)>(vb), S##l1 = tr_read<v_rd_off(D0, 1, 0)>(vb), S##h1 = tr_read<v_rd_off(D0, 1, 1)>(vb), \
    S##l2 = tr_read<v_rd_off(D0, 2, 0)>(vb), S##h2 = tr_read<v_rd_off(D0, 2, 1)>(vb), S##l3 = tr_read<v_rd_off(D0, 3, 0)>(vb), S##h3 = tr_read<v_rd_off(D0, 3, 1)>(vb)
#define TRW(N, S) asm volatile("s_waitcnt lgkmcnt(" #N ")" : "+v"(S##l0), "+v"(S##h0), "+v"(S##l1), "+v"(S##h1), "+v"(S##l2), "+v"(S##h2), "+v"(S##l3), "+v"(S##h3) :: "memory")
#define PVM(od, S) do { od = __builtin_amdgcn_mfma_f32_32x32x16_bf16(pa0, PKV(S##l0, S##h0), od, 0, 0, 0); od = __builtin_amdgcn_mfma_f32_32x32x16_bf16(pa1, PKV(S##l1, S##h1), od, 0, 0, 0); \
    od = __builtin_amdgcn_mfma_f32_32x32x16_bf16(pa2, PKV(S##l2, S##h2), od, 0, 0, 0); od = __builtin_amdgcn_mfma_f32_32x32x16_bf16(pa3, PKV(S##l3, S##h3), od, 0, 0, 0); } while (0)
#define PKV(L, H) (bf16x8){L[0], L[1], L[2], L[3], H[0], H[1], H[2], H[3]}
__device__ __forceinline__ void pv_d0_exp2(f32x16* o, int vb, bf16x8 pa0, bf16x8 pa1, bf16x8 pa2, bf16x8 pa3, f32x16& pn) {
  s16x4 Al0, Ah0, Al1, Ah1, Al2, Ah2, Al3, Ah3, Bl0, Bh0, Bl1, Bh1, Bl2, Bh2, Bl3, Bh3;
#define TRS(S, D0) do { S##l0 = tr_read<v_rd_off(D0, 0, 0)>(vb); S##h0 = tr_read<v_rd_off(D0, 0, 1)>(vb); S##l1 = tr_read<v_rd_off(D0, 1, 0)>(vb); S##h1 = tr_read<v_rd_off(D0, 1, 1)>(vb); \
    S##l2 = tr_read<v_rd_off(D0, 2, 0)>(vb); S##h2 = tr_read<v_rd_off(D0, 2, 1)>(vb); S##l3 = tr_read<v_rd_off(D0, 3, 0)>(vb); S##h3 = tr_read<v_rd_off(D0, 3, 1)>(vb); } while (0)
  TRS(A, 0); TRS(B, 1);
  TRW(8, A); SBAR(); PVM(o[0], A); for (int r = 0; r < 4; ++r) pn[r] = __builtin_amdgcn_exp2f(pn[r]); SBAR();
  TRS(A, 2);
  TRW(8, B); SBAR(); PVM(o[1], B); for (int r = 4; r < 8; ++r) pn[r] = __builtin_amdgcn_exp2f(pn[r]); SBAR();
  TRS(B, 3);
  TRW(8, A); SBAR(); PVM(o[2], A); for (int r = 8; r < 12; ++r) pn[r] = __builtin_amdgcn_exp2f(pn[r]); SBAR();
  TRW(0, B); SBAR(); PVM(o[3], B); for (int r = 12; r < 16; ++r) pn[r] = __builtin_amdgcn_exp2f(pn[r]);
  SBAR();
#undef TRS
}
#undef TR8
#define ATT_SG1() do { if (ATT_SG) { __builtin_amdgcn_sched_group_barrier(0x100, 4, 0); \
    _Pragma("unroll") for (int i_ = 0; i_ < 8; ++i_) { __builtin_amdgcn_sched_group_barrier(0x008, 2, 0); __builtin_amdgcn_sched_group_barrier(0x100, 2, 0); __builtin_amdgcn_sched_group_barrier(0x002, 10, 0); } } } while (0)
template <bool F8Q>
__device__ __forceinline__ void q_norm_rope(bf16x8 (&qr)[8], i32x8 (&qf)[2], const float* __restrict__ qg, const float* __restrict__ ropeR, const float* __restrict__ ropeC, int t0, int wid, int r32, int hi) {
  {
    float sq = 0.f;
#pragma unroll
    for (int d0 = 0; d0 < 8; ++d0) { const u32x4 w = __builtin_bit_cast(u32x4, qr[d0]);
#pragma unroll
      for (int c = 0; c < 4; ++c) { const float a = bf_lo(w[c]), b = bf_hi(w[c]); sq += a * a + b * b; } }
    { auto rr = __builtin_amdgcn_permlane32_swap(__float_as_uint(sq), __float_as_uint(sq), false, false); sq = __uint_as_float(rr[0]) + __uint_as_float(rr[1]); }
    const float rstd = (F8Q ? 8.0f : 1.0f) * (SCALE * 1.4426950408889634f) / sqrtf(sq * (1.0f / 128.0f) + 1e-6f);
    const int t = t0 + wid * QBLK + r32, prow = t >> 6, pcol = t & 63;
#pragma unroll
    for (int pr = 0; pr < 4; ++pr) {
      const int d0a = (pr & 1) + 4 * (pr >> 1), d0b = d0a + 2, fi0 = (pr & 1) * 16 + hi * 8;
      const float* tab = (pr < 2 ? ropeR + (prow * 32 + fi0) * 2 : ropeC + (pcol * 32 + fi0) * 2);
      const u32x4 wa = __builtin_bit_cast(u32x4, qr[d0a]), wb = __builtin_bit_cast(u32x4, qr[d0b]);
      const float* ga = qg + d0a * 16 + hi * 8; const float* gb = qg + d0b * 16 + hi * 8;
      float oa[8], ob[8];
#pragma unroll
      for (int j = 0; j < 8; ++j) {
        const float xa = (j & 1) ? bf_hi(wa[j >> 1]) : bf_lo(wa[j >> 1]), xb = (j & 1) ? bf_hi(wb[j >> 1]) : bf_lo(wb[j >> 1]);
        const float y1 = xa * rstd * ga[j], y2 = xb * rstd * gb[j], cs = tab[2 * j], sn = tab[2 * j + 1];
        oa[j] = y1 * cs - y2 * sn; ob[j] = y2 * cs + y1 * sn; }
      u32x4 pa, pb;
#pragma unroll
      for (int c = 0; c < 4; ++c) { pa[c] = cvt_pk_bf16(oa[2 * c], oa[2 * c + 1]); pb[c] = cvt_pk_bf16(ob[2 * c], ob[2 * c + 1]); }
      if constexpr (F8Q) {
        qf[d0a >> 2][2 * (d0a & 3)] = (int)pack4_fp8(oa[0], oa[1], oa[2], oa[3]); qf[d0a >> 2][2 * (d0a & 3) + 1] = (int)pack4_fp8(oa[4], oa[5], oa[6], oa[7]);
        qf[d0b >> 2][2 * (d0b & 3)] = (int)pack4_fp8(ob[0], ob[1], ob[2], ob[3]); qf[d0b >> 2][2 * (d0b & 3) + 1] = (int)pack4_fp8(ob[4], ob[5], ob[6], ob[7]);
      } else { qr[d0a] = __builtin_bit_cast(bf16x8, pa); qr[d0b] = __builtin_bit_cast(bf16x8, pb); }
    }
  }
}
template <bool FIXED>
__device__ __forceinline__ void attn_dense_body(const bf16_t* Qb, const bf16_t* __restrict__ Kh, const bf16_t* __restrict__ Vh, bf16_t* Ob, int seq, char* lds,
                                                const float* __restrict__ qg, const float* __restrict__ ropeR, const float* __restrict__ ropeC, int t0) {
  const int tid = tid_fresh(), wid = tid >> 6, lane = tid & 63, r32 = lane & 31, hi = lane >> 5;
  bf16_t* V_lds = (bf16_t*)lds; bf16_t* K_lds = (bf16_t*)(lds + 2 * SHM_V);
  float* ws = (float*)(lds + 2 * SHM_V + 2 * SHM_K) + wid * 64; float* li_l = ws; float* al_l = ws + 32;
  float m_reg = -1e30f, l_reg = 0; bf16x8 qr[8];
  const bf16_t* Qw = Qb + (long)(wid * QBLK + r32) * LDQ + hi * 8;
#pragma unroll
  for (int d0 = 0; d0 < 8; ++d0) qr[d0] = *reinterpret_cast<const bf16x8*>(Qw + d0 * 16);
  { i32x8 qf_[2]; q_norm_rope<false>(qr, qf_, qg, ropeR, ropeC, t0, wid, r32, hi); }
  f32x16 o[4] = {};
  const int sr = tid >> 4, sc = (tid & 15) * 8, vst0 = v_st(sr, sc), vst1 = v_st(32 + sr, sc);
  const int vb0 = (int)(uintptr_t)V_lds + v_rd_base(lane);
  constexpr int SDP = FIXED ? ATT_SDEPTH_FIXED : 1;
  struct { bf16x8 vs0, vs1, ks0, ks1; } sr_[SDP];
#define LD8(p) (*reinterpret_cast<const bf16x8*>(p))
#define SLOAD(i, k0) do { sr_[i].vs0 = LD8(&Vh[(long)((k0) + sr) * LDK + sc]); sr_[i].vs1 = LD8(&Vh[(long)((k0) + 32 + sr) * LDK + sc]); \
    sr_[i].ks0 = LD8(&Kh[(long)((k0) + sr) * LDK + sc]); sr_[i].ks1 = LD8(&Kh[(long)((k0) + 32 + sr) * LDK + sc]); } while (0)
#define SWRITE(b, i) do { *(bf16x8*)((char*)V_lds + (b) * SHM_V + vst0) = sr_[i].vs0;          \
    *(bf16x8*)((char*)V_lds + (b) * SHM_V + vst1) = sr_[i].vs1; int kc = sc * 2;               \
    *(bf16x8*)((char*)K_lds + (b) * SHM_K + KSWZ(sr, kc)) = sr_[i].ks0;                       \
    *(bf16x8*)((char*)K_lds + (b) * SHM_K + KSWZ(32 + sr, kc)) = sr_[i].ks1; } while (0)
#define SWAIT() do { if (SDP == 2) asm volatile("s_waitcnt vmcnt(4)" ::: "memory"); else asm volatile("s_waitcnt vmcnt(0)" ::: "memory"); } while (0)
#define RESC(a) do { if (!FIXED && __any((a) < 1.f)) { if (hi == 0) al_l[r32] = (a); asm volatile("s_waitcnt lgkmcnt(0)" ::: "memory"); \
    for (int d = 0; d < 4; ++d) for (int r = 0; r < 16; ++r) o[d][r] *= al_l[crow(r, hi)]; } } while (0)
  f32x16 pA0, pA1, pB0, pB1; float mnA, mnB, alA, alB; bf16x8 pa0, pa1, pa2, pa3; const int NT = seq / KVBLK;
  constexpr int SE = 0, SO = SDP - 1;
  SLOAD(SE, 0); asm volatile("s_waitcnt vmcnt(0)" ::: "memory"); SWRITE(0, SE); __syncthreads();
  qkt(pA0, pA1, K_lds, qr, r32, hi); partialSM<FIXED>(pA0, pA1, m_reg, mnA, alA);
  SLOAD(SO, KVBLK); if (SDP == 2) { if (2 < NT) SLOAD(SE, 2 * KVBLK); }
  SWAIT(); SWRITE(1, SO); __syncthreads();
  for (int j = 1; j + 1 < NT; j += 2) {
    SBAR(); qkt(pB0, pB1, (bf16_t*)((char*)K_lds + SHM_K), qr, r32, hi);
    finishSM(pA0, pA1, alA, l_reg, pa0, pa1, pa2, pa3); ATT_SG1(); SBAR();
    SLOAD(SO, (j + SDP) * KVBLK); SBAR();
    if constexpr (FIXED) { pv_d0_exp(o, vb0, pa0, pa1, pa2, pa3, pB0); alB = 1.f; } else { pv_d0(o, vb0, pa0, pa1, pa2, pa3); partialSM<FIXED>(pB0, pB1, m_reg, mnB, alB); SBAR(); }
    __syncthreads(); SWAIT(); SWRITE(0, SE);
    RESC(alB); __syncthreads();
    SBAR(); qkt(pA0, pA1, K_lds, qr, r32, hi);
    finishSM(pB0, pB1, alB, l_reg, pa0, pa1, pa2, pa3); ATT_SG1(); SBAR();
    if (SDP == 1 || j + 3 < NT) SLOAD(SE, (j + 1 + SDP) * KVBLK); SBAR();
    if constexpr (FIXED) { pv_d0_exp(o, vb0 + (int)SHM_V, pa0, pa1, pa2, pa3, pA0); alA = 1.f; } else { pv_d0(o, vb0 + (int)SHM_V, pa0, pa1, pa2, pa3); partialSM<FIXED>(pA0, pA1, m_reg, mnA, alA); SBAR(); }
    __syncthreads(); SWAIT(); SWRITE(1, SO);
    RESC(alA); __syncthreads();
  }
  SBAR(); qkt(pB0, pB1, (bf16_t*)((char*)K_lds + SHM_K), qr, r32, hi);
  finishSM(pA0, pA1, alA, l_reg, pa0, pa1, pa2, pa3); SBAR();
  if constexpr (FIXED) { pv_d0_exp(o, vb0, pa0, pa1, pa2, pa3, pB0); alB = 1.f; } else { pv_d0(o, vb0, pa0, pa1, pa2, pa3); partialSM<FIXED>(pB0, pB1, m_reg, mnB, alB); SBAR(); }
  __syncthreads(); RESC(alB);
  finishSM(pB0, pB1, alB, l_reg, pa0, pa1, pa2, pa3); SBAR();
  pv_d0(o, vb0 + (int)SHM_V, pa0, pa1, pa2, pa3);
  if (hi == 0) li_l[r32] = l_reg; asm volatile("s_waitcnt lgkmcnt(0)" ::: "memory");
  float rli[16];
#pragma unroll
  for (int r = 0; r < 16; ++r) rli[r] = __builtin_amdgcn_rcpf(li_l[crow(r, hi)]);
  bf16_t* Ow = Ob + (long)(wid * QBLK) * LDQ;
#pragma unroll
  for (int r = 0; r < 16; ++r) { int orow = crow(r, hi);
    for (int d0 = 0; d0 < 4; ++d0) Ow[(long)orow * LDQ + d0 * 32 + r32] = (bf16_t)(cvt_pk_bf16(o[d0][r] * rli[r], 0.f) & 0xffffu); }
  __syncthreads();
#undef LD8
#undef SLOAD
#undef SWRITE
#undef SWAIT
#undef RESC
}

__device__ __forceinline__ void q_norm_rope6(const bf16x8 (&qr)[8], i32x8 (&qf)[2], int (&qsc)[2], const float* __restrict__ qg, const float* __restrict__ ropeR, const float* __restrict__ ropeC, int t0, int wid, int r32, int hi) {
  float sq = 0.f;
#pragma unroll
  for (int d0 = 0; d0 < 8; ++d0) { const u32x4 w = __builtin_bit_cast(u32x4, qr[d0]);
#pragma unroll
    for (int c = 0; c < 4; ++c) { const float a = bf_lo(w[c]), b = bf_hi(w[c]); sq += a * a + b * b; } }
  { auto rr = __builtin_amdgcn_permlane32_swap(__float_as_uint(sq), __float_as_uint(sq), false, false); sq = __uint_as_float(rr[0]) + __uint_as_float(rr[1]); }
  const float rstd = (SCALE * 1.4426950408889634f) / sqrtf(sq * (1.0f / 128.0f) + 1e-6f);
  const int t = t0 + wid * QBLK + r32, prow = t >> 6, pcol = t & 63;
#pragma unroll
  for (int s = 0; s < 2; ++s) { f32x16 A, B; float mx = 0.f;
#pragma unroll
    for (int h2 = 0; h2 < 2; ++h2) { const int pr = 2 * s + h2, d0a = (pr & 1) + 4 * (pr >> 1), d0b = d0a + 2, fi0 = (pr & 1) * 16 + hi * 8;
      const float* tab = (pr < 2 ? ropeR + (prow * 32 + fi0) * 2 : ropeC + (pcol * 32 + fi0) * 2);
      const u32x4 wa = __builtin_bit_cast(u32x4, qr[d0a]), wb = __builtin_bit_cast(u32x4, qr[d0b]);
      const float* ga = qg + d0a * 16 + hi * 8; const float* gb = qg + d0b * 16 + hi * 8;
#pragma unroll
      for (int j = 0; j < 8; ++j) {
        const float xa = (j & 1) ? bf_hi(wa[j >> 1]) : bf_lo(wa[j >> 1]), xb = (j & 1) ? bf_hi(wb[j >> 1]) : bf_lo(wb[j >> 1]);
        const float y1 = xa * rstd * ga[j], y2 = xb * rstd * gb[j], cs = tab[2 * j], sn = tab[2 * j + 1];
        const float va = y1 * cs - y2 * sn, vb = y2 * cs + y1 * sn;
        A[8 * h2 + j] = va; B[8 * h2 + j] = vb; mx = fmaxf(mx, fmaxf(fabsf(va), fabsf(vb))); } }
    unsigned e8 = (__float_as_uint(mx) >> 23) & 0xffu; e8 = (e8 < 8u ? 8u : e8) - 2u;
    const u32x6 p6 = __builtin_amdgcn_cvt_scalef32_2xpk16_fp6_f32(A, B, __uint_as_float(e8 << 23));
    qf[s] = (i32x8){(int)p6[0], (int)p6[1], (int)p6[2], (int)p6[3], (int)p6[4], (int)p6[5], 0, 0}; qsc[s] = (int)(e8 * 0x01010101u); }
}
__device__ __forceinline__ void qkt_f6(f32x16& p0, f32x16& p1, const char* Ks, const i32x8 (&qf)[2], const int (&qsc)[2], int r32, int hi) {
  typedef int i32x2_ __attribute__((ext_vector_type(2)));
  const int k0 = r32, k1 = 32 + r32, h8 = 8 * ((r32 >> 4) & 1);
#define QK6_AD(key, c) (Ks + (key) * 128 + ((((c) + 2 * hi) ^ (((key) >> 1) & 7)) << 4))
  const i32x4 a0 = *(const i32x4*)QK6_AD(k0, 0), b0 = *(const i32x4*)QK6_AD(k1, 0), c0 = *(const i32x4*)QK6_AD(k0, 4), d0 = *(const i32x4*)QK6_AD(k1, 4);
  const i32x2_ a1 = *(const i32x2_*)(QK6_AD(k0, 1) + h8), b1 = *(const i32x2_*)(QK6_AD(k1, 1) + h8), c1 = *(const i32x2_*)(QK6_AD(k0, 5) + h8), d1 = *(const i32x2_*)(QK6_AD(k1, 5) + h8);
  const int sa = *(const int*)(QK6_AD(k0, 1) + (8 ^ h8)), sb = *(const int*)(QK6_AD(k1, 1) + (8 ^ h8));
#undef QK6_AD
#define QK6_8(x, y) __builtin_shufflevector(x, __builtin_shufflevector(y, y, 0, 1, -1, -1), 0, 1, 2, 3, 4, 5, -1, -1)
  p0 = __builtin_amdgcn_mfma_scale_f32_32x32x64_f8f6f4(QK6_8(a0, a1), qf[0], (f32x16){}, 2, 2, 0, sa, 0, qsc[0]);
  p1 = __builtin_amdgcn_mfma_scale_f32_32x32x64_f8f6f4(QK6_8(b0, b1), qf[0], (f32x16){}, 2, 2, 0, sb, 0, qsc[0]);
  p0 = __builtin_amdgcn_mfma_scale_f32_32x32x64_f8f6f4(QK6_8(c0, c1), qf[1], p0, 2, 2, 1, sa, 0, qsc[1]);
  p1 = __builtin_amdgcn_mfma_scale_f32_32x32x64_f8f6f4(QK6_8(d0, d1), qf[1], p1, 2, 2, 1, sb, 0, qsc[1]);
#undef QK6_8
}
__device__ __forceinline__ void qkt_f8(f32x16& p0, f32x16& p1, const char* Ks, const i32x8 (&qf)[2], int r32, int hi) {
  p0 = f32x16{}; p1 = f32x16{};
#pragma unroll
  for (int s = 0; s < 2; ++s) {
    const int k0 = r32, k1 = 32 + r32, c0 = 4 * s + 2 * hi;
    const i32x4 a00 = *(const i32x4*)(Ks + k0 * 128 + (((c0) ^ ((k0 >> 1) & 7)) << 4)), a01 = *(const i32x4*)(Ks + k0 * 128 + (((c0 + 1) ^ ((k0 >> 1) & 7)) << 4));
    const i32x4 a10 = *(const i32x4*)(Ks + k1 * 128 + (((c0) ^ ((k1 >> 1) & 7)) << 4)), a11 = *(const i32x4*)(Ks + k1 * 128 + (((c0 + 1) ^ ((k1 >> 1) & 7)) << 4));
    p0 = __builtin_amdgcn_mfma_scale_f32_32x32x64_f8f6f4(__builtin_shufflevector(a00, a01, 0, 1, 2, 3, 4, 5, 6, 7), qf[s], p0, 0, 0, 0, 0x7f7f7f7f, 0, 0x7c7c7c7c);
    p1 = __builtin_amdgcn_mfma_scale_f32_32x32x64_f8f6f4(__builtin_shufflevector(a10, a11, 0, 1, 2, 3, 4, 5, 6, 7), qf[s], p1, 0, 0, 0, 0x7f7f7f7f, 0, 0x7c7c7c7c);
  }
}
#define ATT_SG8() do { if (ATT_SG) { __builtin_amdgcn_sched_group_barrier(0x100, 8, 0); \
    _Pragma("unroll") for (int i_ = 0; i_ < 4; ++i_) { __builtin_amdgcn_sched_group_barrier(0x008, 1, 0); __builtin_amdgcn_sched_group_barrier(0x002, 20, 0); } } } while (0)
template <bool QK8>
__device__ __forceinline__ void attn_dma_body(const bf16_t* Qb, const bf16_t* __restrict__ Kh, const unsigned char* __restrict__ Kf8h, const bf16_t* __restrict__ Vh, bf16_t* Ob, int seq, char* lds,
                                              const float* __restrict__ qg, const float* __restrict__ ropeR, const float* __restrict__ ropeC, int t0) {
  const int tid = tid_fresh(), wid = __builtin_amdgcn_readfirstlane(tid >> 6), lane = tid & 63, r32 = lane & 31, hi = lane >> 5;
  constexpr int SLOT = 16384, KSL = QK8 ? 8192 : 16384, VOFF = 3 * KSL;
  char* K_l = lds; float* ws = (float*)(lds + VOFF + 3 * SLOT) + wid * 64; float* li_l = ws;
  const unsigned ldsb = (unsigned)(uintptr_t)lds;
  float l_reg = 0; bf16x8 qr[8];
  const bf16_t* Qw = Qb + (long)(wid * QBLK + r32) * LDQ + hi * 8;
#pragma unroll
  for (int d0 = 0; d0 < 8; ++d0) qr[d0] = *reinterpret_cast<const bf16x8*>(Qw + d0 * 16);
  i32x8 qf[2];
  q_norm_rope<QK8>(qr, qf, qg, ropeR, ropeC, t0, wid, r32, hi);
  f32x16 o[4] = {};
  int koff[2], voff[2];
#pragma unroll
  for (int i = 0; i < 2; ++i) { const int P = wid * 128 + i * 64 + lane;
    if constexpr (QK8) { const int P8 = wid * 64 + lane, key = P8 >> 3, c = (P8 & 7) ^ ((key >> 1) & 7); koff[i] = key * 256 + c * 16; }
    else { const int row = P >> 4, c = (P & 15) ^ (row & 7); koff[i] = row * LDK + c * 8; }
    { const int st = P >> 5, rowk = (P & 31) >> 2, cch = P & 3, kk = (st >> 2) * 8 + rowk, k = (kk & ~0xC) | ((kk & 4) << 1) | ((kk & 8) >> 1); voff[i] = k * LDK + (st & 3) * 32 + cch * 8; } }
  const int vb0 = (int)ldsb + VOFF + v_rd_base(lane);
#define DMA_K(slot, tile) do { if constexpr (QK8) { const unsigned char* g8_ = Kf8h + (long)(tile) * (KVBLK * 256); \
        __builtin_amdgcn_global_load_lds((const unsigned*)(g8_ + koff[0]), (LAS unsigned*)(ldsb + (slot) * KSL + wid * 1024), 16, 0, 0); } else { \
    const bf16_t* g_ = Kh + (long)(tile) * (KVBLK * LDK); \
    __builtin_amdgcn_global_load_lds((const unsigned*)(g_ + koff[0]), (LAS unsigned*)(ldsb + (slot) * SLOT + wid * 2048), 16, 0, 0); \
    __builtin_amdgcn_global_load_lds((const unsigned*)(g_ + koff[1]), (LAS unsigned*)(ldsb + (slot) * SLOT + wid * 2048 + 1024), 16, 0, 0); } } while (0)
#define DMA_V(slot, tile) do { const bf16_t* g_ = Vh + (long)(tile) * (KVBLK * LDK); \
    __builtin_amdgcn_global_load_lds((const unsigned*)(g_ + voff[0]), (LAS unsigned*)(ldsb + VOFF + (slot) * SLOT + wid * 2048), 16, 0, 0); \
    __builtin_amdgcn_global_load_lds((const unsigned*)(g_ + voff[1]), (LAS unsigned*)(ldsb + VOFF + (slot) * SLOT + wid * 2048 + 1024), 16, 0, 0); } while (0)
#define KSLOT(s_) ((const bf16_t*)(K_l + (s_) * KSL))
#define QKT(P0, P1, s_) do { if constexpr (QK8) qkt_f8(P0, P1, (const char*)KSLOT(s_), qf, r32, hi); else qkt(P0, P1, KSLOT(s_), qr, r32, hi); } while (0)
  f32x16 pA0, pA1, pB0, pB1; bf16x8 pa0, pa1, pa2, pa3; const int NT = seq / KVBLK;
  DMA_K(0, 0); DMA_V(0, 0); DMA_K(1, 1);
  asm volatile("s_waitcnt vmcnt(0)" ::: "memory"); __builtin_amdgcn_s_barrier(); SBAR();
  QKT(pA0, pA1, 0);
  for (int r = 0; r < 16; ++r) pA0[r] = __builtin_amdgcn_exp2f(pA0[r]);
  DMA_K(2, 2); DMA_V(1, 1);
  __builtin_amdgcn_s_barrier(); SBAR();
#define HALF(PN0, PN1, PO0, PO1, t_, KS, VS, KD, VD) do { const int tk_ = (t_) + 2 < NT ? (t_) + 2 : NT - 1, tv_ = (t_) + 1 < NT ? (t_) + 1 : NT - 1; \
    DMA_K(KD, tk_); DMA_V(VD, tv_); \
    SBAR(); QKT(PN0, PN1, KS); finishSM(PO0, PO1, 1.f, l_reg, pa0, pa1, pa2, pa3); if constexpr (QK8) { ATT_SG8(); } else { ATT_SG1(); } SBAR(); \
    pv_d0_exp2(o, vb0 + (VS) * SLOT, pa0, pa1, pa2, pa3, PN0); \
    if constexpr (QK8) asm volatile("s_waitcnt vmcnt(3)" ::: "memory"); else asm volatile("s_waitcnt vmcnt(4)" ::: "memory"); __builtin_amdgcn_s_barrier(); SBAR(); } while (0)
  int t = 1;
  for (; t + 5 < NT; t += 6) {
    HALF(pB0, pB1, pA0, pA1, t,     1, 0, 0, 2);
    HALF(pA0, pA1, pB0, pB1, t + 1, 2, 1, 1, 0);
    HALF(pB0, pB1, pA0, pA1, t + 2, 0, 2, 2, 1);
    HALF(pA0, pA1, pB0, pB1, t + 3, 1, 0, 0, 2);
    HALF(pB0, pB1, pA0, pA1, t + 4, 2, 1, 1, 0);
    HALF(pA0, pA1, pB0, pB1, t + 5, 0, 2, 2, 1);
  }
  HALF(pB0, pB1, pA0, pA1, t, 1, 0, 0, 2);
  finishSM(pB0, pB1, 1.f, l_reg, pa0, pa1, pa2, pa3); SBAR();
  pv_d0(o, vb0 + 1 * SLOT, pa0, pa1, pa2, pa3);
  if (hi == 0) li_l[r32] = l_reg; asm volatile("s_waitcnt lgkmcnt(0)" ::: "memory");
  float rli[16];
#pragma unroll
  for (int r = 0; r < 16; ++r) rli[r] = __builtin_amdgcn_rcpf(li_l[crow(r, hi)]);
  bf16_t* Ow = Ob + (long)(wid * QBLK) * LDQ;
#pragma unroll
  for (int r = 0; r < 16; ++r) { int orow = crow(r, hi);
    for (int d0 = 0; d0 < 4; ++d0) Ow[(long)orow * LDQ + d0 * 32 + r32] = (bf16_t)(cvt_pk_bf16(o[d0][r] * rli[r], 0.f) & 0xffffu); }
  asm volatile("s_waitcnt vmcnt(0) lgkmcnt(0)" ::: "memory"); __builtin_amdgcn_s_barrier(); SBAR();
#undef DMA_K
#undef DMA_V
#undef KSLOT
#undef QKT
#undef HALF
}

__device__ __forceinline__ void finishSM_f8(f32x16& p0, f32x16& p1, i32x8& pf, int& psc) {
  for (int r = 0; r < 16; ++r) p1[r] = __builtin_amdgcn_exp2f(p1[r]);
  float pm = 0; for (int r = 0; r < 16; ++r) pm = fmaxf(pm, p0[r]); for (int r = 0; r < 16; ++r) pm = fmaxf(pm, p1[r]);
  const unsigned e8 = (__float_as_uint(pm) >> 23) & 0xffu;
  const float mul = __uint_as_float((261u - e8) << 23);
  psc = (int)((e8 - 7u) * 0x01010101u);
#if ATT_SCVT
  typedef short v2s_t __attribute__((ext_vector_type(2)));
  const float qs = (ATT_SCVT == 1) ? __uint_as_float((e8 - 7u) << 23) : mul;
#pragma unroll
  for (int c = 0; c < 4; ++c) { v2s_t w = {0, 0};
    w = __builtin_amdgcn_cvt_scalef32_pk_fp8_f32(w, p0[4 * c], p0[4 * c + 1], qs, false); w = __builtin_amdgcn_cvt_scalef32_pk_fp8_f32(w, p0[4 * c + 2], p0[4 * c + 3], qs, true); pf[c] = __builtin_bit_cast(int, w);
    v2s_t u = {0, 0};
    u = __builtin_amdgcn_cvt_scalef32_pk_fp8_f32(u, p1[4 * c], p1[4 * c + 1], qs, false); u = __builtin_amdgcn_cvt_scalef32_pk_fp8_f32(u, p1[4 * c + 2], p1[4 * c + 3], qs, true); pf[4 + c] = __builtin_bit_cast(int, u); }
#else
#pragma unroll
  for (int c = 0; c < 4; ++c) { pf[c] = (int)pack4_fp8_nc(p0[4 * c] * mul, p0[4 * c + 1] * mul, p0[4 * c + 2] * mul, p0[4 * c + 3] * mul);
                                pf[4 + c] = (int)pack4_fp8_nc(p1[4 * c] * mul, p1[4 * c + 1] * mul, p1[4 * c + 2] * mul, p1[4 * c + 3] * mul); }
#endif
}
__device__ __forceinline__ void finishSM_f8_tail(f32x16& p0, f32x16& p1, i32x8& pf, int& psc) {
  float pm = 0; for (int r = 0; r < 16; ++r) pm = fmaxf(pm, p0[r]); for (int r = 0; r < 16; ++r) pm = fmaxf(pm, p1[r]);
  const unsigned e8 = (__float_as_uint(pm) >> 23) & 0xffu;
  const float mul = __uint_as_float((261u - e8) << 23);
  psc = (int)((e8 - 7u) * 0x01010101u);
#if ATT_SCVT
  typedef short v2s_t __attribute__((ext_vector_type(2)));
  const float qs = (ATT_SCVT == 1) ? __uint_as_float((e8 - 7u) << 23) : mul;
#pragma unroll
  for (int c = 0; c < 4; ++c) { v2s_t w = {0, 0};
    w = __builtin_amdgcn_cvt_scalef32_pk_fp8_f32(w, p0[4 * c], p0[4 * c + 1], qs, false); w = __builtin_amdgcn_cvt_scalef32_pk_fp8_f32(w, p0[4 * c + 2], p0[4 * c + 3], qs, true); pf[c] = __builtin_bit_cast(int, w);
    v2s_t u = {0, 0};
    u = __builtin_amdgcn_cvt_scalef32_pk_fp8_f32(u, p1[4 * c], p1[4 * c + 1], qs, false); u = __builtin_amdgcn_cvt_scalef32_pk_fp8_f32(u, p1[4 * c + 2], p1[4 * c + 3], qs, true); pf[4 + c] = __builtin_bit_cast(int, u); }
#else
#pragma unroll
  for (int c = 0; c < 4; ++c) { pf[c] = (int)pack4_fp8_nc(p0[4 * c] * mul, p0[4 * c + 1] * mul, p0[4 * c + 2] * mul, p0[4 * c + 3] * mul);
                                pf[4 + c] = (int)pack4_fp8_nc(p1[4 * c] * mul, p1[4 * c + 1] * mul, p1[4 * c + 2] * mul, p1[4 * c + 3] * mul); }
#endif
}
__device__ __forceinline__ void o_bf16_to_fp8(const bf16_t* Qp, unsigned char* O8p) {
  __syncthreads();
  const int tid = tid_fresh(), row = tid >> 1, c0 = (tid & 1) * 64;
#pragma unroll
  for (int q = 0; q < 4; ++q) { const u32x4 w0 = *(const u32x4*)(Qp + (size_t)row * 1024 + c0 + 16 * q), w1 = *(const u32x4*)(Qp + (size_t)row * 1024 + c0 + 16 * q + 8);
    u32x4 o; o.x = pack4_fp8(bf_lo(w0.x) * 8.f, bf_hi(w0.x) * 8.f, bf_lo(w0.y) * 8.f, bf_hi(w0.y) * 8.f); o.y = pack4_fp8(bf_lo(w0.z) * 8.f, bf_hi(w0.z) * 8.f, bf_lo(w0.w) * 8.f, bf_hi(w0.w) * 8.f);
    o.z = pack4_fp8(bf_lo(w1.x) * 8.f, bf_hi(w1.x) * 8.f, bf_lo(w1.y) * 8.f, bf_hi(w1.y) * 8.f); o.w = pack4_fp8(bf_lo(w1.z) * 8.f, bf_hi(w1.z) * 8.f, bf_lo(w1.w) * 8.f, bf_hi(w1.w) * 8.f);
    *(u32x4*)(O8p + (size_t)row * 1024 + c0 + 16 * q) = o; }
  __syncthreads();
}
__device__ __forceinline__ void attn_f8_body(const bf16_t* Qb, const unsigned char* __restrict__ Kf8h, const unsigned char* __restrict__ Vt8h, bf16_t* Ob, int seq, char* lds,
                                             const float* __restrict__ qg, const float* __restrict__ ropeR, const float* __restrict__ ropeC, int t0) {
  const int tid = tid_fresh(), wid = __builtin_amdgcn_readfirstlane(tid >> 6), lane = tid & 63, r32 = lane & 31, hi = lane >> 5;
  constexpr int KSL = 8192, VSL = 8192, VOFF = 8 * KSL;
  char* K_l = lds;
  const unsigned ldsb = (unsigned)(uintptr_t)lds;
  bf16x8 qr[8];
  const bf16_t* Qw = Qb + (long)(wid * QBLK + r32) * LDQ + hi * 8;
#pragma unroll
  for (int d0 = 0; d0 < 8; ++d0) qr[d0] = *reinterpret_cast<const bf16x8*>(Qw + d0 * 16);
  i32x8 qf[2]; int qsc[2];
  q_norm_rope6(qr, qf, qsc, qg, ropeR, ropeC, t0, wid, r32, hi);
  f32x16 o[4] = {}; f32x16 lacc = {};
  const i32x6 ones6 = {0x08208208, (int)0x82082082, 0x20820820, 0x08208208, (int)0x82082082, 0x20820820};
  int koff, voff;
  { const int P = wid * 64 + lane;
    { const int key = P >> 3, c = (P & 7) ^ ((key >> 1) & 7); koff = key * 256 + c * 16; }
    { const int d = P >> 2, c = (P & 3) ^ ((d >> 2) & 3); voff = d * 64 + c * 16; } }
  const char* vr0 = lds + VOFF + r32 * 64 + (((2 * hi) ^ ((r32 >> 2) & 3)) << 4); const char* vr1 = lds + VOFF + r32 * 64 + (((2 * hi + 1) ^ ((r32 >> 2) & 3)) << 4);
  const int one_sc = 0x7f7f7f7f;
  typedef int i32x2_t __attribute__((ext_vector_type(2)));
  const int h8 = 8 * ((r32 >> 4) & 1);
  const char* vr1d = vr1 + h8; const char* vr1s = vr1 + (8 ^ h8);
#define DMA_K(slot, tile) __builtin_amdgcn_global_load_lds((const unsigned*)(Kf8h + (long)(tile) * (KVBLK * 256) + koff), (LAS unsigned*)(ldsb + (slot) * KSL + wid * 1024), 16, 0, 0)
#define DMA_V(slot, tile) __builtin_amdgcn_global_load_lds((const unsigned*)(Vt8h + (long)(tile) * 8192 + voff), (LAS unsigned*)(ldsb + VOFF + (slot) * VSL + wid * 1024), 16, 0, 0)
#define PVL() asm volatile("s_nop 7\n\tv_mfma_scale_f32_32x32x64_f8f6f4 %0, %1, %2, %0, %3, %4 op_sel_hi:[0,0,0] cbsz:2 blgp:2" : "+v"(lacc) : "v"(pf), "v"(ones6), "v"(psc), "v"(one_sc))
  f32x16 pA0, pA1, pB0, pB1; i32x6 pf; int psc; const int NT = seq / KVBLK;
  i32x6 kf00, kf01, kf10, kf11; int ks0, ks1;
  DMA_K(0, 0); DMA_V(0, 0); DMA_K(1, 1); DMA_K(2, 2);
  asm volatile("s_waitcnt vmcnt(0)" ::: "memory"); __builtin_amdgcn_s_barrier(); SBAR();
  qkt_f6(pA0, pA1, K_l, qf, qsc, r32, hi);
  for (int r = 0; r < 16; ++r) pA0[r] = __builtin_amdgcn_exp2f(pA0[r]);
  DMA_V(1, 1); DMA_K(3, 3); DMA_V(2, 2); DMA_K(4, 4); DMA_V(3, 3);
  typedef short v2s_t __attribute__((ext_vector_type(2)));
#define VLD(D0, VS, dst) do { const i32x4 b0_ = *(const i32x4*)(vr0 + (VS) * VSL + (D0) * 2048); const i32x2_t b1_ = *(const i32x2_t*)(vr1d + (VS) * VSL + (D0) * 2048); \
    dst = __builtin_shufflevector(b0_, __builtin_shufflevector(b1_, b1_, 0, 1, -1, -1), 0, 1, 2, 3, 4, 5); } while (0)
#define VLDS(VS) do { vsc = *(const int*)(vr1s + (VS) * VSL); } while (0)
#define PVM(D0, vb, SEL) asm volatile("v_mfma_scale_f32_32x32x64_f8f6f4 %0, %1, %2, %0, %3, %4 " SEL " cbsz:2 blgp:2" : "+v"(o[D0]) : "v"(pf), "v"(vb), "v"(psc), "v"(vsc))
#define SEL0 "op_sel_hi:[0,0,0]"
#define SEL1 "op_sel:[0,1,0] op_sel_hi:[0,0,0]"
#define SEL2 "op_sel_hi:[0,1,0]"
#define SEL3 "op_sel:[0,1,0] op_sel_hi:[0,1,0]"
#define EXPS(P, lo, hi_) do { for (int r = (lo); r < (hi_); ++r) P[r] = __builtin_amdgcn_exp2f(P[r]); } while (0)
#define KADDR(KS, key, c) (K_l + (KS) * KSL + (key) * 128 + ((((c) + 2 * hi) ^ (((key) >> 1) & 7)) << 4))
#define KLD1(KS, dst, key, c) do { const i32x4 a_ = *(const i32x4*)KADDR(KS, key, c); const i32x2_t b_ = *(const i32x2_t*)(KADDR(KS, key, (c) + 1) + h8); \
    dst = __builtin_shufflevector(a_, __builtin_shufflevector(b_, b_, 0, 1, -1, -1), 0, 1, 2, 3, 4, 5); } while (0)
#define KLD2(KS, d0_, d1_, c) do { const char* p0_ = KADDR(KS, r32, c); const char* p1_ = KADDR(KS, r32, (c) + 1) + h8; \
    const i32x4 a_ = *(const i32x4*)p0_, e_ = *(const i32x4*)(p0_ + 4096); const i32x2_t b_ = *(const i32x2_t*)p1_, f_ = *(const i32x2_t*)(p1_ + 4096); \
    d0_ = __builtin_shufflevector(a_, __builtin_shufflevector(b_, b_, 0, 1, -1, -1), 0, 1, 2, 3, 4, 5); d1_ = __builtin_shufflevector(e_, __builtin_shufflevector(f_, f_, 0, 1, -1, -1), 0, 1, 2, 3, 4, 5); } while (0)
#define KLDS2(KS) do { const char* ps_ = KADDR(KS, r32, 1) + (8 ^ h8); ks0 = *(const int*)ps_; ks1 = *(const int*)(ps_ + 4096); } while (0)
#define KLDS(KS, dst, key) do { dst = *(const int*)(KADDR(KS, key, 1) + (8 ^ h8)); } while (0)
#define KLD(KS) do { KLD1(KS, kf00, r32, 0); KLD1(KS, kf10, 32 + r32, 0); KLDS2(KS); KLD1(KS, kf01, r32, 4); KLD1(KS, kf11, 32 + r32, 4); } while (0)
#define K8(x) __builtin_shufflevector(x, x, 0, 1, 2, 3, 4, 5, -1, -1)
#define HALF8(PN0, PN1, PO0, PO1, t_, KSN, VS, KD, VD, BAR) do { const int tk_ = (t_) + 4 < NT ? (t_) + 4 : NT - 1, tv_ = (t_) + 3 < NT ? (t_) + 3 : NT - 1; \
    DMA_K(KD, tk_); DMA_V(VD, tv_); SBAR(); i32x6 va_, vb_; int vsc; \
    PN0 = __builtin_amdgcn_mfma_scale_f32_32x32x64_f8f6f4(K8(kf00), qf[0], (f32x16){}, 2, 2, 0, ks0, 0, qsc[0]); asm volatile("" : "+v"(PN0)); SBAR(); \
    EXPS(PO1, 0, 8); SBAR(); \
    PN1 = __builtin_amdgcn_mfma_scale_f32_32x32x64_f8f6f4(K8(kf10), qf[0], (f32x16){}, 2, 2, 0, ks1, 0, qsc[0]); asm volatile("" : "+v"(PN1)); SBAR(); \
    EXPS(PO1, 8, 16); VLD(0, VS, va_); VLDS(VS); SBAR(); \
    PN0 = __builtin_amdgcn_mfma_scale_f32_32x32x64_f8f6f4(K8(kf01), qf[1], PN0, 2, 2, 1, ks0, 0, qsc[1]); asm volatile("" : "+v"(PN0)); SBAR(); \
    float pm_ = 0, pn_ = 0; for (int r = 0; r < 16; ++r) pm_ = fmaxf(pm_, PO0[r]); for (int r = 0; r < 16; ++r) pn_ = fmaxf(pn_, PO1[r]); pm_ = fmaxf(pm_, pn_); \
    const unsigned e8_ = ((__float_as_uint(pm_) >> 23) & 0xffu) - 2u; const float qs_ = __uint_as_float(e8_ << 23); \
    VLD(1, VS, vb_); SBAR(); \
    PN1 = __builtin_amdgcn_mfma_scale_f32_32x32x64_f8f6f4(K8(kf11), qf[1], PN1, 2, 2, 1, ks1, 0, qsc[1]); asm volatile("" : "+v"(PN1)); SBAR(); \
    pf = __builtin_bit_cast(i32x6, __builtin_amdgcn_cvt_scalef32_2xpk16_fp6_f32(PO0, PO1, qs_)); psc = (int)e8_; SBAR(); \
    PVL(); SBAR(); KLD1(KSN, kf00, r32, 0); KLDS2(KSN); EXPS(PN0, 0, 4); SBAR(); \
    PVM(0, va_, SEL0); SBAR(); VLD(2, VS, va_); KLD1(KSN, kf10, 32 + r32, 0); EXPS(PN0, 4, 8); SBAR(); \
    PVM(1, vb_, SEL1); SBAR(); VLD(3, VS, vb_); KLD1(KSN, kf01, r32, 4); EXPS(PN0, 8, 12); SBAR(); \
    PVM(2, va_, SEL2); SBAR(); KLD1(KSN, kf11, 32 + r32, 4); EXPS(PN0, 12, 16); SBAR(); \
    PVM(3, vb_, SEL3); SBAR(); \
    if (BAR) { asm volatile("s_waitcnt vmcnt(3)" ::: "memory"); __builtin_amdgcn_s_barrier(); } SBAR(); } while (0)
  KLD(1);
  asm volatile("s_waitcnt vmcnt(3)" ::: "memory"); __builtin_amdgcn_s_barrier(); SBAR();
  int t = 1;
#define STEP8(i, PN0, PN1, PO0, PO1) HALF8(PN0, PN1, PO0, PO1, t + (i), ((i) + 2) & 7, (i) & 7, ((i) + 5) & 7, ((i) + 4) & 7, ((i) & 1))
  for (; t + 8 <= NT - 7; t += 8) {
    STEP8(0, pB0, pB1, pA0, pA1); STEP8(1, pA0, pA1, pB0, pB1); STEP8(2, pB0, pB1, pA0, pA1); STEP8(3, pA0, pA1, pB0, pB1);
    STEP8(4, pB0, pB1, pA0, pA1); STEP8(5, pA0, pA1, pB0, pB1); STEP8(6, pB0, pB1, pA0, pA1); STEP8(7, pA0, pA1, pB0, pB1);
  }
  STEP8(0, pB0, pB1, pA0, pA1); STEP8(1, pA0, pA1, pB0, pB1); STEP8(2, pB0, pB1, pA0, pA1); STEP8(3, pA0, pA1, pB0, pB1);
  STEP8(4, pB0, pB1, pA0, pA1); STEP8(5, pA0, pA1, pB0, pB1); STEP8(6, pB0, pB1, pA0, pA1);
#undef STEP8
  for (int r = 0; r < 16; ++r) pB1[r] = __builtin_amdgcn_exp2f(pB1[r]);
  { float pm_ = 0; for (int r = 0; r < 16; ++r) pm_ = fmaxf(pm_, pB0[r]); for (int r = 0; r < 16; ++r) pm_ = fmaxf(pm_, pB1[r]);
    const unsigned e8_ = ((__float_as_uint(pm_) >> 23) & 0xffu) - 2u;
    pf = __builtin_bit_cast(i32x6, __builtin_amdgcn_cvt_scalef32_2xpk16_fp6_f32(pB0, pB1, __uint_as_float(e8_ << 23))); psc = (int)(e8_ * 0x01010101u); }
  SBAR();
  { i32x6 va_, vb_; int vsc; VLD(0, 7, va_); VLDS(7); VLD(1, 7, vb_); PVL(); PVM(0, va_, SEL0); PVM(1, vb_, SEL1); VLD(2, 7, va_); VLD(3, 7, vb_); PVM(2, va_, SEL2); PVM(3, vb_, SEL3); }
  asm volatile("s_nop 15\n\ts_nop 15\n\ts_nop 15\n\ts_nop 15\n\ts_nop 15" ::: "memory");
  float rli[16];
#pragma unroll
  for (int r = 0; r < 16; ++r) rli[r] = __builtin_amdgcn_rcpf(lacc[r]);
  if (MIX_F8) {
    unsigned char* O8w = (unsigned char*)Ob + (long)(wid * QBLK) * 1024;
#pragma unroll
    for (int r = 0; r < 16; ++r) { const int orow = crow(r, hi); const float sc8 = rli[r] * 8.0f;
      *(unsigned*)(O8w + (long)orow * 1024 + 4 * r32) = pack4_fp8(o[0][r] * sc8, o[1][r] * sc8, o[2][r] * sc8, o[3][r] * sc8); }
  } else {
  bf16_t* Ow = Ob + (long)(wid * QBLK) * LDQ;
#pragma unroll
  for (int r = 0; r < 16; ++r) { int orow = crow(r, hi);
    *(u32x2*)(Ow + (long)orow * LDQ + 4 * r32) = (u32x2){cvt_pk_bf16(o[0][r] * rli[r], o[1][r] * rli[r]), cvt_pk_bf16(o[2][r] * rli[r], o[3][r] * rli[r])}; }
  }
  asm volatile("s_waitcnt vmcnt(0) lgkmcnt(0)" ::: "memory"); __builtin_amdgcn_s_barrier(); SBAR();
#undef DMA_K
#undef DMA_V
#undef PV8
#undef PVL
#undef HALF8
#undef VLD
#undef PVM
#undef SEL0
#undef SEL1
#undef SEL2
#undef SEL3
#undef VLDS
#undef KLDS
#undef KLD2
#undef KLDS2
#undef K8
#undef KLD
#undef KLD1
#undef KADDR
#undef EXPS
}

#ifndef ATT_SGP_MODE
#define ATT_SGP_MODE 1
#endif
#define ATT_SGP() do { if (ATT_SGP_MODE == 1) { __builtin_amdgcn_sched_group_barrier(0x100, 4, 0); \
    __builtin_amdgcn_sched_group_barrier(0x008, 1, 0); __builtin_amdgcn_sched_group_barrier(0x100, 4, 0); __builtin_amdgcn_sched_group_barrier(0x002, 20, 0); \
    __builtin_amdgcn_sched_group_barrier(0x008, 1, 0); __builtin_amdgcn_sched_group_barrier(0x002, 20, 0); \
    __builtin_amdgcn_sched_group_barrier(0x008, 1, 0); __builtin_amdgcn_sched_group_barrier(0x002, 20, 0); \
    __builtin_amdgcn_sched_group_barrier(0x008, 1, 0); __builtin_amdgcn_sched_group_barrier(0x002, 20, 0); } else if (ATT_SGP_MODE == 2) { ATT_SG8(); } } while (0)
template <bool LAG>
__device__ __forceinline__ void attn_f8p_body(const bf16_t* Qb, const unsigned char* __restrict__ Kf8h, const unsigned char* __restrict__ Vt8h, bf16_t* Ob, int seq, char* lds,
                                              const float* __restrict__ qg, const float* __restrict__ ropeR, const float* __restrict__ ropeC, int t0) {
  const int tid = tid_fresh(), wid = __builtin_amdgcn_readfirstlane(tid >> 6), lane = tid & 63, r32 = lane & 31, hi = lane >> 5;
  constexpr int KSL = 8192, VSL = 8192, VOFF = 3 * KSL;
  char* K_l = lds;
  const unsigned ldsb = (unsigned)(uintptr_t)lds;
  bf16x8 qr[8];
  const bf16_t* Qw = Qb + (long)(wid * QBLK + r32) * LDQ + hi * 8;
#pragma unroll
  for (int d0 = 0; d0 < 8; ++d0) qr[d0] = *reinterpret_cast<const bf16x8*>(Qw + d0 * 16);
  i32x8 qf[2];
  q_norm_rope<true>(qr, qf, qg, ropeR, ropeC, t0, wid, r32, hi);
  f32x16 o[4], lacc;
  { float z_ = 0.f; asm volatile("" : "+v"(z_));
#pragma unroll
    for (int r = 0; r < 16; ++r) { o[0][r] = z_; o[1][r] = z_; o[2][r] = z_; o[3][r] = z_; lacc[r] = z_; } }
  const i32x8 ones8 = {0x38383838, 0x38383838, 0x38383838, 0x38383838, 0x38383838, 0x38383838, 0x38383838, 0x38383838};
  int koff, voff;
  { const int P = wid * 64 + lane;
    { const int key = P >> 3, c = (P & 7) ^ ((key >> 1) & 7); koff = key * 256 + c * 16; }
    { const int d = P >> 2, c = (P & 3) ^ ((d >> 2) & 3); voff = d * 64 + c * 16; } }
  const unsigned vr0 = ldsb + VOFF + r32 * 64 + (((2 * hi) ^ ((r32 >> 2) & 3)) << 4), vr1 = ldsb + VOFF + r32 * 64 + (((2 * hi + 1) ^ ((r32 >> 2) & 3)) << 4);
  const int one_sc = 0x7f7f7f7f;
#define DMA_K(slotoff, tile) __builtin_amdgcn_global_load_lds((const unsigned*)(Kf8h + (long)(tile) * (KVBLK * 256) + koff), (LAS unsigned*)(ldsb + (slotoff) + wid * 1024), 16, 0, 0)
#define DMA_V(slotoff, tile) __builtin_amdgcn_global_load_lds((const unsigned*)(Vt8h + (long)(tile) * 8192 + voff), (LAS unsigned*)(ldsb + VOFF + (slotoff) + wid * 1024), 16, 0, 0)
#define PVL() asm volatile("s_nop 7\n\tv_mfma_scale_f32_32x32x64_f8f6f4 %0, %1, %2, %0, %3, %4 op_sel_hi:[0,0,0]" : "+v"(lacc) : "v"(pf), "v"(ones8), "v"(psc), "v"(one_sc))
#define PV8(D0, vso) do { const i32x4 b0_ = *(const LAS i32x4*)(vr0 + (vso) + (D0) * 2048), b1_ = *(const LAS i32x4*)(vr1 + (vso) + (D0) * 2048); \
    const i32x8 vb_ = __builtin_shufflevector(b0_, b1_, 0, 1, 2, 3, 4, 5, 6, 7); \
    asm volatile("s_nop 1\n\tv_mfma_scale_f32_32x32x64_f8f6f4 %0, %1, %2, %0, %3, %4 op_sel_hi:[0,0,0]" : "+v"(o[D0]) : "v"(pf), "v"(vb_), "v"(psc), "v"(one_sc)); } while (0)
#define REG_PV(vso, PE) do { PVL(); PV8(0, vso); for (int r = 0; r < 4; ++r) PE[r] = __builtin_amdgcn_exp2f(PE[r]); \
    PV8(1, vso); for (int r = 4; r < 8; ++r) PE[r] = __builtin_amdgcn_exp2f(PE[r]); \
    PV8(2, vso); for (int r = 8; r < 12; ++r) PE[r] = __builtin_amdgcn_exp2f(PE[r]); \
    PV8(3, vso); for (int r = 12; r < 16; ++r) PE[r] = __builtin_amdgcn_exp2f(PE[r]); SBAR(); } while (0)
#define REG_QF(PN0, PN1, kso, PO0, PO1) do { SBAR(); qkt_f8(PN0, PN1, K_l + (kso), qf, r32, hi); finishSM_f8(PO0, PO1, pf, psc); ATT_SGP(); SBAR(); } while (0)
  f32x16 pA0, pA1, pB0, pB1; i32x8 pf; int psc; const int NT = seq / KVBLK;
  DMA_K(0, 0); DMA_V(0, 0); DMA_K(KSL, 1);
  asm volatile("s_waitcnt vmcnt(0)" ::: "memory"); __builtin_amdgcn_s_barrier(); SBAR();
  qkt_f8(pA0, pA1, K_l, qf, r32, hi);
  if constexpr (!LAG) { for (int r = 0; r < 16; ++r) pA0[r] = __builtin_amdgcn_exp2f(pA0[r]); }
  DMA_K(2 * KSL, 2); DMA_V(VSL, 1);
  __builtin_amdgcn_s_barrier(); SBAR();
#define STEP(PN0, PN1, PO0, PO1, t_) do { const int tt_ = (t_), tk_ = tt_ + 2 < NT ? tt_ + 2 : NT - 1, tv_ = tt_ + 1 < NT ? tt_ + 1 : NT - 1; \
    DMA_K(((tt_ + 2) % 3) * KSL, tk_); DMA_V(((tt_ + 1) & 3) * VSL, tv_); \
    if constexpr (!LAG) { REG_QF(PN0, PN1, (tt_ % 3) * KSL, PO0, PO1); REG_PV(((tt_ - 1) & 3) * VSL, PN0); } \
    else { if (tt_ >= 2) { REG_PV(((tt_ - 2) & 3) * VSL, PO0); } else { for (int r = 0; r < 16; ++r) PO0[r] = __builtin_amdgcn_exp2f(PO0[r]); SBAR(); } \
           REG_QF(PN0, PN1, (tt_ % 3) * KSL, PO0, PO1); } \
    asm volatile("s_waitcnt vmcnt(2)" ::: "memory"); __builtin_amdgcn_s_barrier(); SBAR(); } while (0)
  int t = 1;
  for (; t + 1 < NT; t += 2) { STEP(pB0, pB1, pA0, pA1, t); STEP(pA0, pA1, pB0, pB1, t + 1); }
  STEP(pB0, pB1, pA0, pA1, t);
  if constexpr (!LAG) { finishSM_f8(pB0, pB1, pf, psc); SBAR(); PVL(); PV8(0, ((NT - 1) & 3) * VSL); PV8(1, ((NT - 1) & 3) * VSL); PV8(2, ((NT - 1) & 3) * VSL); PV8(3, ((NT - 1) & 3) * VSL); }
  else { REG_PV(((NT - 2) & 3) * VSL, pB0); finishSM_f8(pB0, pB1, pf, psc); SBAR(); PVL(); PV8(0, ((NT - 1) & 3) * VSL); PV8(1, ((NT - 1) & 3) * VSL); PV8(2, ((NT - 1) & 3) * VSL); PV8(3, ((NT - 1) & 3) * VSL); }
  asm volatile("s_nop 15\n\ts_nop 15\n\ts_nop 15\n\ts_nop 15\n\ts_nop 15" ::: "memory");
  float rli[16];
#pragma unroll
  for (int r = 0; r < 16; ++r) rli[r] = __builtin_amdgcn_rcpf(lacc[r]);
  bf16_t* Ow = Ob + (long)(wid * QBLK) * LDQ;
#pragma unroll
  for (int r = 0; r < 16; ++r) { int orow = crow(r, hi);
    for (int d0 = 0; d0 < 4; ++d0) Ow[(long)orow * LDQ + d0 * 32 + r32] = (bf16_t)(cvt_pk_bf16(o[d0][r] * rli[r], 0.f) & 0xffffu); }
  asm volatile("s_waitcnt vmcnt(0) lgkmcnt(0)" ::: "memory"); __builtin_amdgcn_s_barrier(); SBAR();
#undef DMA_K
#undef DMA_V
#undef PV8
#undef PVL
#undef REG_PV
#undef REG_QF
#undef STEP
}
}

namespace dft {
__device__ __forceinline__ unsigned off_b(unsigned row, unsigned ch) { return 256u * row + 16u * (ch ^ (((row & 3) << 2) | ((row >> 2) & 3))); }
__device__ __forceinline__ unsigned tr_read_addr(unsigned lane, unsigned c, unsigned ks, unsigned t) {
  const unsigned h = lane >> 5, blk = (lane >> 4) & 1, q = (lane & 15) >> 2, p = lane & 3;
  return off_b(16 * ks + 8 * h + 4 * t + q, 4 * c + 2 * blk + (p >> 1)) + 8 * (p & 1);
}
template <int OFF> __device__ __forceinline__ s16x4 tr_rd_o(unsigned a) { s16x4 r; asm volatile("ds_read_b64_tr_b16 %0, %1 offset:%2" : "=&v"(r) : "v"(a), "i"(OFF) : "memory"); return r; }
template <int KS, bool OUT8 = false>
__device__ __forceinline__ void dft_unit(LAS unsigned char* lds, const bf16_t* Amat, const bf16_t* bbase, size_t bstride, bf16_t* obase, size_t ostride, u32x4 (&st)[KS * 16 * 16 / NTHR], const bf16_t* bnext) {
    constexpr int KK = 16 * KS, NLD = KK * 16 / NTHR;
    const int tid = tid_fresh(), wid = tid >> 6, lane = tid & 63, mi = wid & 3, nh = wid >> 2, hi = lane >> 5;
    bf16x8 afr[KS];
#pragma unroll
    for (int ks = 0; ks < KS; ++ks) afr[ks] = *(const bf16x8*)(Amat + (size_t)(32 * mi + (lane & 31)) * KK + 16 * ks + 8 * hi);
    const unsigned ldsb = (unsigned)(uintptr_t)lds;
    unsigned ta[2][2][2];
#pragma unroll
    for (int cc = 0; cc < 2; ++cc)
#pragma unroll
        for (int l_ = 0; l_ < 2; ++l_)
#pragma unroll
            for (int t_ = 0; t_ < 2; ++t_) ta[cc][l_][t_] = ldsb + tr_read_addr(lane, 2 * nh + cc, l_, t_);
    const unsigned wbase = (unsigned)(((tid >> 4) >> 5) * 8192) + off_b((tid >> 4) & 31, tid & 15);
    for (int ch = 0; ch < 4; ++ch) {
        __syncthreads();
#pragma unroll
        for (int i = 0; i < NLD; ++i) *(LAS u32x4*)(lds + wbase + i * 8192) = st[i];
        if (ch < 3) {
#pragma unroll
            for (int i = 0; i < NLD; ++i) st[i] = *(const u32x4*)(bbase + i * bstride + (ch + 1) * 128);
        } else if (bnext) {
#pragma unroll
            for (int i = 0; i < NLD; ++i) st[i] = *(const u32x4*)(bnext + i * bstride);
        }
        __syncthreads();
        f32x16 acc0 = {}, acc1 = {};
#define DFT_STEP(ks) { constexpr int o_ = ((ks) >> 1) * 8192; constexpr int l_ = (ks) & 1; \
            const s16x4 a0 = tr_rd_o<o_>(ta[0][l_][0]), a1 = tr_rd_o<o_>(ta[0][l_][1]), b0 = tr_rd_o<o_>(ta[1][l_][0]), b1 = tr_rd_o<o_>(ta[1][l_][1]); \
            asm volatile("s_waitcnt lgkmcnt(0)" ::: "memory"); __builtin_amdgcn_sched_barrier(0); \
            acc0 = __builtin_amdgcn_mfma_f32_32x32x16_bf16(afr[ks], (bf16x8){a0[0], a0[1], a0[2], a0[3], a1[0], a1[1], a1[2], a1[3]}, acc0, 0, 0, 0); \
            acc1 = __builtin_amdgcn_mfma_f32_32x32x16_bf16(afr[ks], (bf16x8){b0[0], b0[1], b0[2], b0[3], b1[0], b1[1], b1[2], b1[3]}, acc1, 0, 0, 0); }
        DFT_STEP(0) DFT_STEP(1) DFT_STEP(2) DFT_STEP(3) DFT_STEP(4) DFT_STEP(5) DFT_STEP(6) DFT_STEP(7)
        if constexpr (KS == 16) { DFT_STEP(8) DFT_STEP(9) DFT_STEP(10) DFT_STEP(11) DFT_STEP(12) DFT_STEP(13) DFT_STEP(14) DFT_STEP(15) }
#undef DFT_STEP
        { LAS unsigned char* stg = lds + 65536 + wid * 4608; const int l_ = lane & 31, row2 = lane >> 1, half = lane & 1;
          if constexpr (OUT8) {
#pragma unroll
            for (int r = 0; r < 16; ++r) { const int row = (r & 3) + 8 * (r >> 2) + 4 * hi; const unsigned w = pack4_fp8(acc0[r], acc1[r], 0.f, 0.f);
                stg[row * 80 + l_] = (unsigned char)(w & 0xffu); stg[row * 80 + 32 + l_] = (unsigned char)((w >> 8) & 0xffu); }
            asm volatile("s_waitcnt lgkmcnt(0)" ::: "memory");
            const u32x4 q0 = *(const LAS u32x4*)(stg + row2 * 80 + half * 32), q1 = *(const LAS u32x4*)(stg + row2 * 80 + half * 32 + 16);
            unsigned char* g = (unsigned char*)obase - (size_t)(4 * hi) * ostride - l_ + (size_t)row2 * ostride + ch * 128 + 64 * nh + half * 32;
            *(u32x4*)g = q0; *(u32x4*)(g + 16) = q1;
          } else {
#pragma unroll
            for (int r = 0; r < 16; ++r) { const int row = (r & 3) + 8 * (r >> 2) + 4 * hi;
                *(LAS unsigned short*)(stg + row * 144 + 2 * l_) = (unsigned short)(cvt_pk_bf16(acc0[r], 0.f) & 0xffffu); *(LAS unsigned short*)(stg + row * 144 + 64 + 2 * l_) = (unsigned short)(cvt_pk_bf16(acc1[r], 0.f) & 0xffffu); }
            asm volatile("s_waitcnt lgkmcnt(0)" ::: "memory");
            bf16_t* g = obase - (size_t)(4 * hi) * ostride - l_ + (size_t)row2 * ostride + ch * 128 + 64 * nh + half * 32;
#pragma unroll
            for (int k = 0; k < 4; ++k) *(u32x4*)(g + 8 * k) = *(const LAS u32x4*)(stg + row2 * 144 + half * 64 + 16 * k);
          }
          asm volatile("s_waitcnt lgkmcnt(0)" ::: "memory");
        }
    }
    __syncthreads();
}
}

struct Args { const float* in[20]; float* out; unsigned char* ws; };
struct Frame {
    LAS unsigned char* lds; int tid, lane, wave, vcu, G; unsigned char* ws;
    __device__ __forceinline__ void fresh() { tid = tid_fresh(); lane = tid & 63; wave = __builtin_amdgcn_readfirstlane(tid >> 6); }
};

__device__ __forceinline__ void p0_transpose_item(const float* W, int ldw, int K, int k0, int nsrc0, bf16_t* WT, int drow0, LAS float* scr, int lane) {
#pragma unroll 8
    for (int i = 0; i < 32; ++i) { const int kk = 2 * i + (lane >> 5); scr[kk * 33 + (lane & 31)] = W[(size_t)(k0 + kk) * ldw + nsrc0 + (lane & 31)]; }
    LDS_WAIT(); asm volatile("" ::: "memory");
    const int c = lane & 7;
#pragma unroll
    for (int j = 0; j < 4; ++j) { const int n = (lane >> 3) + 8 * j; const LAS float* s = scr + (8 * c) * 33 + n;
        u32x4 o; o.x = cvt_pk_bf16(s[0 * 33], s[1 * 33]); o.y = cvt_pk_bf16(s[2 * 33], s[3 * 33]); o.z = cvt_pk_bf16(s[4 * 33], s[5 * 33]); o.w = cvt_pk_bf16(s[6 * 33], s[7 * 33]);
        *(u32x4*)(WT + (size_t)(drow0 + n) * K + k0 + 8 * c) = o; }
    LDS_WAIT(); asm volatile("" ::: "memory");
}

__device__ __forceinline__ void p0_transpose_item_f8(const float* W, int ldw, int K, int k0, int nsrc0, unsigned char* WT, int drow0, float sc, LAS float* scr, int lane) {
#pragma unroll 8
    for (int i = 0; i < 32; ++i) { const int kk = 2 * i + (lane >> 5); scr[kk * 33 + (lane & 31)] = W[(size_t)(k0 + kk) * ldw + nsrc0 + (lane & 31)]; }
    LDS_WAIT(); asm volatile("" ::: "memory");
    const int c = lane & 3;
#pragma unroll
    for (int j = 0; j < 2; ++j) { const int n = (lane >> 2) + 16 * j; const LAS float* s = scr + (16 * c) * 33 + n;
        u32x4 o; o.x = pack4_fp8(s[0 * 33] * sc, s[1 * 33] * sc, s[2 * 33] * sc, s[3 * 33] * sc); o.y = pack4_fp8(s[4 * 33] * sc, s[5 * 33] * sc, s[6 * 33] * sc, s[7 * 33] * sc);
        o.z = pack4_fp8(s[8 * 33] * sc, s[9 * 33] * sc, s[10 * 33] * sc, s[11 * 33] * sc); o.w = pack4_fp8(s[12 * 33] * sc, s[13 * 33] * sc, s[14 * 33] * sc, s[15 * 33] * sc);
        *(u32x4*)(WT + (size_t)(drow0 + n) * K + k0 + 16 * c) = o; }
    LDS_WAIT(); asm volatile("" ::: "memory");
}
__device__ __forceinline__ void p0_prologue(Frame& F, const Args& a) {
    F.fresh();
    const float* c_in = a.in[1]; const float* w_ada = a.in[2]; const float* b_ada = a.in[3]; const float* w_in = a.in[4];
    const float* w_fourier = a.in[7]; const float* w_attn_o = a.in[8]; const float* w_out = a.in[9]; const float* w_gu = a.in[14]; const float* w_dn = a.in[16];
    unsigned char* ws = F.ws;
    LAS float* scr = (LAS float*)(F.lds + F.wave * 8448);
    LAS float* silu = (LAS float*)(F.lds + 73728);
    LAS float* ctab = (LAS float*)(F.lds + 73728 + 32768);
    LAS float* stab = ctab + 128;
    for (int i = F.tid; i < 8192; i += NTHR) { const float v = c_in[i]; silu[i] = v * sigmoidf_(v); }
    if (F.tid < 128) { ctab[F.tid] = cospif((float)F.tid * (1.0f / 64.0f)); stab[F.tid] = sinpif((float)F.tid * (1.0f / 64.0f)); }
    __syncthreads();
    const int gw = F.vcu * NWAVES + F.wave, NGW = F.G * NWAVES;
    if (gw == 0) {
        float gq_ = fmaxf(fabsf(a.in[5][F.lane]), fabsf(a.in[5][64 + F.lane])), gk_ = fmaxf(fabsf(a.in[6][F.lane]), fabsf(a.in[6][64 + F.lane]));
#pragma unroll
        for (int o_ = 1; o_ < 64; o_ <<= 1) { gq_ = fmaxf(gq_, __shfl_xor(gq_, o_)); gk_ = fmaxf(gk_, __shfl_xor(gk_, o_)); }
        if (F.lane == 0) *(float*)(ws + WS_CTL + 61 * 1024) = 11.313708498984761f * gq_ * gk_ * 1.01f; }
    constexpr int I_IN = 16 * 112, I_F = 8 * 32, I_AO = 16 * 32, I_OUT = 16 * 32, I_GU = NE * 16 * 64, I_DN = NE * 16 * 32;
    constexpr int NITEMS = I_IN + I_F + I_AO + I_OUT + I_GU + I_DN;
    for (int it = gw; it < NITEMS; it += NGW) {
        int r = it;
        if (r < I_IN) { const int kb = r / 112, nb = r % 112;
            if (INPROJ_F8) p0_transpose_item_f8(w_in, 4096, 1024, 64 * kb, 512 + 32 * nb, ws + WS_WIN, 1024 + 32 * nb, 32.0f, scr, F.lane);
            else p0_transpose_item(w_in, 4096, 1024, 64 * kb, 512 + 32 * nb, (bf16_t*)(ws + WS_WIN), 1024 + 32 * nb, scr, F.lane);
            continue; } r -= I_IN;
        if (r < I_F) { const int kb = r / 32, nb = r % 32; if (MIX_F8) p0_transpose_item_f8(w_fourier, 1024, 512, 64 * kb, 32 * nb, ws + WS_WF, 32 * nb, 16.0f, scr, F.lane); else p0_transpose_item(w_fourier, 1024, 512, 64 * kb, 32 * nb, (bf16_t*)(ws + WS_WF), 32 * nb, scr, F.lane); continue; } r -= I_F;
        if (r < I_AO) { const int kb = r / 32, nb = r % 32; if (MIX_F8) p0_transpose_item_f8(w_attn_o, 1024, 1024, 64 * kb, 32 * nb, ws + WS_WAO, 32 * nb, 32.0f, scr, F.lane); else p0_transpose_item(w_attn_o, 1024, 1024, 64 * kb, 32 * nb, (bf16_t*)(ws + WS_WAO), 32 * nb, scr, F.lane); continue; } r -= I_AO;
        if (r < I_OUT) { const int kb = r / 32, nb = r % 32; if (MIX_F8) p0_transpose_item_f8(w_out, 1024, 1024, 64 * kb, 32 * nb, ws + WS_WOUT, 32 * nb, 32.0f, scr, F.lane); else p0_transpose_item(w_out, 1024, 1024, 64 * kb, 32 * nb, (bf16_t*)(ws + WS_WOUT), 32 * nb, scr, F.lane); continue; } r -= I_OUT;
        if (r < I_GU) { const int e = r / 1024, q = r % 1024, kb = q / 64, nb = q % 64; const int n0 = 32 * nb, j = n0 & 1023, isup = n0 >> 10;
            p0_transpose_item_f8(w_gu + (size_t)e * 1024 * 2048, 2048, 1024, 64 * kb, n0, (ws + WS_WGU) + (size_t)e * 2048 * 1024, (j >> 7) * 256 + isup * 128 + (j & 127), 32.0f, scr, F.lane); continue; } r -= I_GU;
        { const int e = r / 512, q = r % 512, kb = q / 32, nb = q % 32;
            p0_transpose_item_f8(w_dn + (size_t)e * 1024 * 1024, 1024, 1024, 64 * kb, 32 * nb, (ws + WS_WD) + (size_t)e * 1024 * 1024, 32 * nb, 32.0f, scr, F.lane); }
    }
    for (int it = gw; it < 2048; it += NGW) {
        const int rg = it >> 7, kg = it & 127, r = rg * 64 + F.lane, ri = r >> 9, gI = (r >> 7) & 3, j = r & 127, k0 = kg * 8;
        float acc[8];
#pragma unroll
        for (int kk = 0; kk < 8; ++kk) acc[kk] = 0.f;
        const LAS float* tb = ri ? stab : ctab;
#pragma unroll 8
        for (int c = 0; c < 128; ++c) { const float t = tb[(c * j) & 127];
#pragma unroll
            for (int kk = 0; kk < 8; ++kk) acc[kk] = fmaf(w_in[(size_t)(k0 + kk) * 4096 + gI * 128 + c], t, acc[kk]); }
        const float sc = 0.08838834764831845f;
        if (INPROJ_F8) { const float s8 = sc * 32.0f;
            *(u32x2*)(ws + WS_WIN + (size_t)r * 1024 + k0) = (u32x2){pack4_fp8(acc[0] * s8, acc[1] * s8, acc[2] * s8, acc[3] * s8), pack4_fp8(acc[4] * s8, acc[5] * s8, acc[6] * s8, acc[7] * s8)}; }
        else {
        u32x4 o; o.x = cvt_pk_bf16(acc[0] * sc, acc[1] * sc); o.y = cvt_pk_bf16(acc[2] * sc, acc[3] * sc); o.z = cvt_pk_bf16(acc[4] * sc, acc[5] * sc); o.w = cvt_pk_bf16(acc[6] * sc, acc[7] * sc);
        *(u32x4*)((bf16_t*)(ws + WS_WIN) + (size_t)r * 1024 + k0) = o; }
    }
    const int gt = F.vcu * NTHR + F.tid, NGT = F.G * NTHR;
    for (int i = gt; i < 128 * 128; i += NGT) {
        const int m = i >> 7, kap = i & 127, k1 = m & 63, ro = m >> 6, s1 = kap >> 1, ri = kap & 1, idx = (k1 * s1) & 63;
        const float cs = cospif((float)idx * (1.0f / 32.0f)), sn = sinpif((float)idx * (1.0f / 32.0f));
        const float v = (ro == 0 ? (ri == 0 ? cs : -sn) : (ri == 0 ? -sn : -cs)) * 0.125f;
        ((bf16_t*)(ws + WS_M1))[i] = (bf16_t)(cvt_pk_bf16(v, 0.f) & 0xffffu);
    }
    for (int i = gt; i < 64 * 128 * 32; i += NGT) {
        const int k1 = i >> 12, k2 = (i >> 5) & 127, s20 = (i & 31) * 4; float v[8];
#pragma unroll
        for (int q = 0; q < 4; ++q) { const int n = ((k1 + 64 * k2) * (s20 + q)) & 8191; const float x = (float)n * (1.0f / 4096.0f);
            v[2 * q] = cospif(x) * 0.08838834764831845f; v[2 * q + 1] = sinpif(x) * 0.08838834764831845f; }
        u32x4 o; o.x = cvt_pk_bf16(v[0], v[1]); o.y = cvt_pk_bf16(v[2], v[3]); o.z = cvt_pk_bf16(v[4], v[5]); o.w = cvt_pk_bf16(v[6], v[7]);
        *(u32x4*)((bf16_t*)(ws + WS_ETAB) + (size_t)i * 8) = o;
    }
    for (int i = gt; i < (128 + 64) * 32; i += NGT) {
        const int p = i >> 5, fi = i & 31; const float freq = exp2f(-(float)fi * (13.287712379549449f / 32.0f));
        const float pos = (float)(p < 128 ? p : p - 128); const float ang = pos * freq;
        float* dst = (p < 128) ? (float*)(ws + WS_ROPE_R) + (p * 32 + fi) * 2 : (float*)(ws + WS_ROPE_C) + ((p - 128) * 32 + fi) * 2;
        dst[0] = cosf(ang); dst[1] = sinf(ang);
    }
    __syncthreads();
    LAS float* red = (LAS float*)F.lds;
    for (int it = F.vcu; it < 96; it += F.G) {
        const int col = it * 64 + F.lane; float acc[8];
#pragma unroll
        for (int b = 0; b < 8; ++b) acc[b] = 0.f;
        const int kb = F.wave * 128;
#pragma unroll 16
        for (int k = 0; k < 128; ++k) { const float w = w_ada[(size_t)(kb + k) * 6144 + col];
#pragma unroll
            for (int b = 0; b < 8; ++b) acc[b] = fmaf(silu[b * 1024 + kb + k], w, acc[b]); }
#pragma unroll
        for (int b = 0; b < 8; ++b) red[(F.wave * 8 + b) * 64 + F.lane] = acc[b];
        __syncthreads();
        { const int b = F.wave; float sum = b_ada[col];
#pragma unroll
            for (int w8 = 0; w8 < 8; ++w8) sum += red[(w8 * 8 + b) * 64 + F.lane];
            ((float*)(ws + WS_MOD))[b * 6144 + col] = sum; }
        __syncthreads();
    }
}

__device__ __forceinline__ void p1_adaln(Frame& F, const float* x) {
    F.fresh();
    const float* mod = (const float*)(F.ws + WS_MOD); bf16_t* U = (bf16_t*)(F.ws + WS_U);
    const int gw = F.vcu * NWAVES + F.wave, NGW = F.G * NWAVES;
    const int per = (NTOK + NGW - 1) / NGW; int bcur = -1; f32x4 shr[4], scr[4];
    const int m_end = (gw + 1) * per < NTOK ? (gw + 1) * per : NTOK;
    f32x4 nxr[2][4];
#pragma unroll
    for (int p = 0; p < 2; ++p) if (gw * per + p < m_end) {
#pragma unroll
        for (int j = 0; j < 4; ++j) nxr[p][j] = ((const f32x4*)(x + (size_t)(gw * per + p) * D) + F.lane)[64 * j]; }
    for (int m = gw * per; m < m_end; ++m) {
        const int b = m / SEQ;
        if (b != bcur) { bcur = b; const f32x4* shp = (const f32x4*)(mod + b * 6144) + F.lane; const f32x4* scp = (const f32x4*)(mod + b * 6144 + 1024) + F.lane;
#pragma unroll
            for (int j = 0; j < 4; ++j) { shr[j] = shp[64 * j]; scr[j] = scp[64 * j] + 1.0f; } }
        f32x4 v[4]; float s = 0.f;
#pragma unroll
        for (int j = 0; j < 4; ++j) { v[j] = nxr[0][j]; nxr[0][j] = nxr[1][j]; s += (v[j][0] + v[j][1]) + (v[j][2] + v[j][3]); }
        if (m + 2 < m_end) {
#pragma unroll
            for (int j = 0; j < 4; ++j) nxr[1][j] = ((const f32x4*)(x + (size_t)(m + 2) * D) + F.lane)[64 * j]; }
        const float mean = wave_sum(s) * (1.f / D); float s2 = 0.f;
#pragma unroll
        for (int j = 0; j < 4; ++j) { v[j] = v[j] - mean; s2 += (v[j][0] * v[j][0] + v[j][1] * v[j][1]) + (v[j][2] * v[j][2] + v[j][3] * v[j][3]); }
        const float rstd = 1.f / sqrtf(wave_sum(s2) * (1.f / D) + 1e-6f);
        u32x2* o8 = (u32x2*)(U + (size_t)m * D) + F.lane; unsigned* o4 = (unsigned*)((unsigned char*)U + (size_t)m * D) + F.lane;
#pragma unroll
        for (int j = 0; j < 4; ++j) { const f32x4 y = v[j] * rstd * scr[j] + shr[j];
            if (INPROJ_F8) o4[64 * j] = pack4_fp8(y[0], y[1], y[2], y[3]);
            else o8[64 * j] = (u32x2){cvt_pk_bf16(y[0], y[1]), cvt_pk_bf16(y[2], y[3])}; }
    }
}

__device__ __forceinline__ void p3_qknorm_rope(Frame& F, const float* qg, const float* kg) {
    F.fresh();
    bf16_t* Q = (bf16_t*)(F.ws + WS_Q); bf16_t* Kb = (bf16_t*)(F.ws + WS_K);
    const float* ropeR = (const float*)(F.ws + WS_ROPE_R); const float* ropeC = (const float*)(F.ws + WS_ROPE_C);
    const int gw = F.vcu * NWAVES + F.wave, NGW = F.G * NWAVES, hl = F.lane & 31, hh = F.lane >> 5;
    const int fi0 = 4 * (hl & 7); const bool isx2 = (hl & 8) != 0, iscol = (hl & 16) != 0;
    const f32x4 gq = *(const f32x4*)(qg + 4 * hl), gk = *(const f32x4*)(kg + 4 * hl);
    for (int t4 = gw; t4 < NTOK; t4 += 4 * NGW) {
      u32x2 wq[4]; f32x4 c01q[4], c23q[4];
#pragma unroll
      for (int q = 0; q < 4; ++q) { const int tkn = t4 + q * NGW; if (tkn < NTOK) {
          const int t = tkn % SEQ, prow = t / 64, pcol = t % 64;
          const float* tab = iscol ? ropeC + (pcol * 32 + fi0) * 2 : ropeR + (prow * 32 + fi0) * 2;
          c01q[q] = *(const f32x4*)tab; c23q[q] = *(const f32x4*)(tab + 4); wq[q] = *(const u32x2*)(Kb + (size_t)tkn * 256 + hh * 128 + 4 * hl); } }
#pragma unroll
      for (int q = 0; q < 4; ++q) { const int tkn = t4 + q * NGW; if (tkn >= NTOK) break;
        const f32x4 cs01 = c01q[q], cs23 = c23q[q];
        const float cc[4] = {cs01[0], cs01[2], cs23[0], cs23[2]}, ss[4] = {cs01[1], cs01[3], cs23[1], cs23[3]};
        {
            const int head = 8 + hh;
            bf16_t* p = Kb + (size_t)tkn * 256 + (head - 8) * 128 + 4 * hl;
            const u32x2 w = wq[q];
            float xv[4] = {bf_lo(w.x), bf_hi(w.x), bf_lo(w.y), bf_hi(w.y)};
            float sq = xv[0] * xv[0] + xv[1] * xv[1] + xv[2] * xv[2] + xv[3] * xv[3];
#pragma unroll
            for (int o = 1; o < 32; o <<= 1) sq += __shfl_xor(sq, o);
            const float rstd = 1.0f / sqrtf(sq * (1.0f / 128.0f) + 1e-6f);
            const f32x4 gg = head < 8 ? gq : gk;
            float y[4], yp[4], r[4];
#pragma unroll
            for (int e = 0; e < 4; ++e) { y[e] = xv[e] * rstd * gg[e]; yp[e] = __shfl_xor(y[e], 8); }
#pragma unroll
            for (int e = 0; e < 4; ++e) r[e] = isx2 ? (y[e] * cc[e] + yp[e] * ss[e]) : (y[e] * cc[e] - yp[e] * ss[e]);
            *(u32x2*)p = (u32x2){cvt_pk_bf16(r[0], r[1]), cvt_pk_bf16(r[2], r[3])};
            if (ATT_QK8) {
                const int pos = 64 * (hl >> 4) + 32 * ((hl & 3) >> 1) + 8 * ((hl & 15) >> 2) + 4 * (hl & 1);
                *(unsigned*)(F.ws + WS_KF8 + (size_t)tkn * 256 + (head - 8) * 128 + pos) = pack4_fp8(r[0], r[1], r[2], r[3]); }
            if (ATT_QK6) {
                LAS float* Lk = (LAS float*)(F.lds + 65536) + F.wave * 256 + hh * 128;
                asm volatile("" ::: "memory");
                *(LAS f32x4*)(Lk + 4 * hl) = (f32x4){r[0], r[1], r[2], r[3]};
                asm volatile("s_waitcnt lgkmcnt(0)" ::: "memory"); __builtin_amdgcn_wave_barrier();
                if (hl < 4) { const int s_ = hl >> 1, g_ = hl & 1; f32x16 A, B; float mx = 0.f;
#pragma unroll
                    for (int q4 = 0; q4 < 8; ++q4) { const int d0p = q4 >> 1, j4 = q4 & 1; const f32x4 v = *(LAS f32x4*)(Lk + 64 * s_ + 16 * d0p + 8 * g_ + 4 * j4);
#pragma unroll
                        for (int e = 0; e < 4; ++e) { const int idx = 8 * d0p + 4 * j4 + e; if (idx < 16) A[idx] = v[e]; else B[idx - 16] = v[e]; mx = fmaxf(mx, fabsf(v[e])); } }
                    unsigned e8 = (__float_as_uint(mx) >> 23) & 0xffu; e8 = (e8 < 8u ? 8u : e8) - 2u;
                    const u32x6 p6 = __builtin_amdgcn_cvt_scalef32_2xpk16_fp6_f32(A, B, __uint_as_float(e8 << 23));
                    unsigned char* dst = F.ws + WS_K6 + (size_t)tkn * 256 + (head - 8) * 128 + hl * 32;
                    const unsigned e8o = (unsigned)__shfl_xor((int)e8, 2); const unsigned pk = s_ == 0 ? (e8 | (e8o << 8)) : (e8o | (e8 << 8));
                    *(u32x4*)dst = (u32x4){p6[0], p6[1], p6[2], p6[3]}; *(u32x4*)(dst + 16) = (tkn & 16) ? (u32x4){pk, 0u, p6[4], p6[5]} : (u32x4){p6[4], p6[5], pk, 0u}; }
                asm volatile("s_waitcnt lgkmcnt(0)" ::: "memory"); __builtin_amdgcn_wave_barrier(); }
        }
      }
    }
}


__device__ __forceinline__ void p3_vt8(Frame& F) {
    F.fresh();
    const bf16_t* V = (const bf16_t*)(F.ws + WS_V); unsigned char* VT = F.ws + WS_VT8;
    LAS bf16_t* Ls = (LAS bf16_t*)F.lds;
    u32x4 nv0, nv1;
#define VT_SRC(u_) (V + ((size_t)(((u_) >> 8) * SEQ + ((u_) & 127) * 64)) * 256 + (((u_) >> 7) & 1) * 128 + (size_t)(F.tid >> 3) * 256 + (F.tid & 7) * 16)
    if (F.vcu < BATCH * 2 * 128) { nv0 = *(const u32x4*)VT_SRC(F.vcu); nv1 = *(const u32x4*)(VT_SRC(F.vcu) + 8); }
    for (int u = F.vcu; u < BATCH * 2 * 128; u += F.G) {
        { const int key = F.tid >> 3, c16 = (F.tid & 7) * 16;
          *(LAS u32x4*)(Ls + key * 136 + c16) = nv0; *(LAS u32x4*)(Ls + key * 136 + c16 + 8) = nv1; }
        if (u + F.G < BATCH * 2 * 128) { nv0 = *(const u32x4*)VT_SRC(u + F.G); nv1 = *(const u32x4*)(VT_SRC(u + F.G) + 8); }
        __syncthreads();
#if ATT_PV6
        if (F.tid < 256) { const int d = F.tid >> 1, g = F.tid & 1, ds = 4 * (d & 31) + (d >> 5); f32x16 v0, v1; float mx = 0.f;
#pragma unroll
          for (int r = 0; r < 16; ++r) { const int key = (r & 3) + 8 * (r >> 2) + 4 * g; v0[r] = bf_lo((unsigned)Ls[key * 136 + ds]); v1[r] = bf_lo((unsigned)Ls[(32 + key) * 136 + ds]);
              mx = fmaxf(mx, fmaxf(fabsf(v0[r]), fabsf(v1[r]))); }
          unsigned e8 = (__float_as_uint(mx) >> 23) & 0xffu; e8 = (e8 < 8u ? 8u : e8) - 2u;
          const u32x6 p = __builtin_amdgcn_cvt_scalef32_2xpk16_fp6_f32(v0, v1, __uint_as_float(e8 << 23));
          LAS unsigned char* scb = (LAS unsigned char*)(F.lds + 24576);
          scb[d * 2 + g] = (unsigned char)e8;
          __syncthreads();
          const int dl = d & 31; const unsigned pk = (unsigned)scb[dl * 2 + g] | ((unsigned)scb[(dl + 32) * 2 + g] << 8) | ((unsigned)scb[(dl + 64) * 2 + g] << 16) | ((unsigned)scb[(dl + 96) * 2 + g] << 24);
          u32x4 o0, o1; o0.x = p[0]; o0.y = p[1]; o0.z = p[2]; o0.w = p[3];
          if (d & 16) { o1.x = pk; o1.y = 0u; o1.z = p[4]; o1.w = p[5]; } else { o1.x = p[4]; o1.y = p[5]; o1.z = pk; o1.w = 0u; }
          *(u32x4*)(VT + (size_t)u * 8192 + d * 64 + g * 32) = o0; *(u32x4*)(VT + (size_t)u * 8192 + d * 64 + g * 32 + 16) = o1; }
        else __syncthreads();
#else
        { const int d = F.tid >> 2, c = F.tid & 3; float v[16];
#pragma unroll
          for (int mm = 0; mm < 16; ++mm) { const int i = 16 * c + mm, g = i >> 5, m = i & 31, r = m & 15, key = (m >> 4) * 32 + (r & 3) + 8 * (r >> 2) + 4 * g;
              v[mm] = bf_lo((unsigned)Ls[key * 136 + d]); }
          u32x4 o; o.x = pack4_fp8(v[0], v[1], v[2], v[3]); o.y = pack4_fp8(v[4], v[5], v[6], v[7]); o.z = pack4_fp8(v[8], v[9], v[10], v[11]); o.w = pack4_fp8(v[12], v[13], v[14], v[15]);
          *(u32x4*)(VT + (size_t)u * 8192 + d * 64 + c * 16) = o; }
#endif
        __syncthreads();
    }
}
#undef VT_SRC
__device__ __forceinline__ void p7_ln_router(Frame& F, const Args& a) {
    F.fresh();
    const float* ln1g = a.in[10]; const float* ln1b = a.in[11]; const float* w_router = a.in[12]; const float* b_router = a.in[13];
    const float* mod = (const float*)(F.ws + WS_MOD); unsigned char* U2 = F.ws + WS_U2; float* X1 = a.out;
    int* tope = (int*)(F.ws + WS_TOPE); float* topw = (float*)(F.ws + WS_TOPW); int* rank = (int*)(F.ws + WS_RANK); int* hist = (int*)(F.ws + WS_HIST);
    float* st1 = (float*)(F.ws + WS_ST1);
    typedef _Float16 h16x8 __attribute__((ext_vector_type(8)));
    typedef _Float16 h16x4 __attribute__((ext_vector_type(4)));
    LAS _Float16* wT = (LAS _Float16*)F.lds;
    _Float16* U2h = (_Float16*)(F.ws + WS_ACT);
    LAS float* lg = (LAS float*)(F.lds + 131072) + F.wave * 132;
    LAS int* le = (LAS int*)(F.lds + 131072 + 8 * 132 * 4 + 128);
    for (int i = F.tid; i < 32 * 1024; i += NTHR) { const int k = i >> 5, e = i & 31; wT[e * 1032 + k] = (_Float16)w_router[i]; }
    __syncthreads();
    f32x4 g1r[4], b1r[4];
#pragma unroll
    for (int j = 0; j < 4; ++j) { g1r[j] = ((const f32x4*)ln1g)[(j >> 1) * 128 + 2 * F.lane + (j & 1)]; b1r[j] = ((const f32x4*)ln1b)[(j >> 1) * 128 + 2 * F.lane + (j & 1)]; }
    for (int unit = F.vcu; unit < NTOK / 256; unit += F.G) {
        const int b = (unit * 256) / SEQ;
        f32x4 shr[4], scr[4];
#pragma unroll
        for (int j = 0; j < 4; ++j) { shr[j] = ((const f32x4*)(mod + b * 6144 + 3 * 1024))[(j >> 1) * 128 + 2 * F.lane + (j & 1)]; scr[j] = ((const f32x4*)(mod + b * 6144 + 4 * 1024))[(j >> 1) * 128 + 2 * F.lane + (j & 1)] + 1.0f; }
        u32x4 nx[2][2];
        { const int tokp = unit * 256 + F.wave * 32;
#pragma unroll
          for (int q = 0; q < 2; ++q) { const u32x4* xr = (const u32x4*)(X1 + (size_t)(tokp + q) * D) + F.lane;
#pragma unroll
            for (int g = 0; g < 2; ++g) nx[q][g] = xr[64 * g]; } }
        for (int pass = 0; pass < 16; ++pass) {
            const int tok0 = unit * 256 + F.wave * 32 + pass * 2;
            f32x4 uu[2][4];
#pragma unroll
            for (int q = 0; q < 2; ++q)
#pragma unroll
                for (int g = 0; g < 2; ++g) { uu[q][2 * g] = (f32x4){bf_lo(nx[q][g].x), bf_hi(nx[q][g].x), bf_lo(nx[q][g].y), bf_hi(nx[q][g].y)}; uu[q][2 * g + 1] = (f32x4){bf_lo(nx[q][g].z), bf_hi(nx[q][g].z), bf_lo(nx[q][g].w), bf_hi(nx[q][g].w)}; }
            if (pass < 15) {
#pragma unroll
                for (int q = 0; q < 2; ++q) { const u32x4* xr = (const u32x4*)(X1 + (size_t)(tok0 + 2 + q) * D) + F.lane;
#pragma unroll
                    for (int g = 0; g < 2; ++g) nx[q][g] = xr[64 * g]; }
            }
#pragma unroll
            for (int q = 0; q < 2; ++q) {
                f32x4 (&v)[4] = uu[q]; float s = 0.f, s2 = 0.f;
#pragma unroll
                for (int j = 0; j < 4; ++j) { s += (v[j][0] + v[j][1]) + (v[j][2] + v[j][3]); s2 += (v[j][0] * v[j][0] + v[j][1] * v[j][1]) + (v[j][2] * v[j][2] + v[j][3] * v[j][3]); }
                wave_sum2(s, s2);
                float mean = s * (1.f / D); float rstd = 1.f / sqrtf(fmaxf(s2 * (1.f / D) - mean * mean, 0.f) + 1e-5f);
                if (F.lane == 0) *(f32x2*)(st1 + (size_t)(tok0 + q) * 2) = (f32x2){mean, rstd};
                s = 0.f; s2 = 0.f;
#pragma unroll
                for (int j = 0; j < 4; ++j) { v[j] = (v[j] - mean) * rstd * g1r[j] + b1r[j];
                    s += (v[j][0] + v[j][1]) + (v[j][2] + v[j][3]); s2 += (v[j][0] * v[j][0] + v[j][1] * v[j][1]) + (v[j][2] * v[j][2] + v[j][3] * v[j][3]); }
                wave_sum2(s, s2);
                mean = s * (1.f / D); rstd = 1.f / sqrtf(fmaxf(s2 * (1.f / D) - mean * mean, 0.f) + 1e-6f);
#pragma unroll
                for (int j = 0; j < 4; ++j) v[j] = v[j] - mean;
                u32x2* o8 = (u32x2*)(U2 + (size_t)(tok0 + q) * D) + F.lane; h16x8* oh = (h16x8*)(U2h + (size_t)(tok0 + q) * D) + F.lane;
#pragma unroll
                for (int g = 0; g < 2; ++g) { const f32x4 ya = v[2 * g] * rstd * scr[2 * g] + shr[2 * g], yb = v[2 * g + 1] * rstd * scr[2 * g + 1] + shr[2 * g + 1];
                    o8[64 * g] = (u32x2){pack4_fp8(ya[0], ya[1], ya[2], ya[3]), pack4_fp8(yb[0], yb[1], yb[2], yb[3])};
                    oh[64 * g] = (h16x8){(_Float16)ya[0], (_Float16)ya[1], (_Float16)ya[2], (_Float16)ya[3], (_Float16)yb[0], (_Float16)yb[1], (_Float16)yb[2], (_Float16)yb[3]}; }
            }
        }
        VM_WAIT();
        {
            const int tokw = unit * 256 + F.wave * 32, r32 = F.lane & 31, hi = F.lane >> 5;
            const _Float16* arow = U2h + (size_t)(tokw + r32) * D + 8 * hi; const LAS _Float16* brow = wT + r32 * 1032 + 8 * hi;
            f32x16 lacc = {};
#pragma unroll 8
            for (int st = 0; st < 64; ++st) {
                const h16x8 af = *(const h16x8*)(arow + 16 * st); const h16x8 bf = *(const LAS h16x8*)(brow + 16 * st);
                lacc = __builtin_amdgcn_mfma_f32_32x32x16_f16(af, bf, lacc, 0, 0, 0);
            }
            const float br = b_router[r32];
#pragma unroll
            for (int r = 0; r < 16; ++r) {
                const int q = hi, e = r32; const float x = lacc[r] + br;
                lg[q * 32 + e] = x; LDS_WAIT(); asm volatile("" ::: "memory");
                int rk = 0;
#pragma unroll
                for (int c4 = 0; c4 < 8; ++c4) { const f32x4 y = *(const LAS f32x4*)(lg + q * 32 + 4 * c4);
#pragma unroll
                    for (int k = 0; k < 4; ++k) { const int e2 = 4 * c4 + k; rk += (y[k] > x || (y[k] == x && e2 < e)) ? 1 : 0; } }
                if (rk < 4) { lg[64 + q * 8 + rk] = x; lg[64 + q * 8 + 4 + rk] = __int_as_float(e); }
                LDS_WAIT(); asm volatile("" ::: "memory");
                if (e == 0) { const int tl = (r & 3) + 8 * (r >> 2) + 4 * hi, tok = tokw + tl; const f32x4 tv = *(const LAS f32x4*)(lg + 64 + q * 8), tif = *(const LAS f32x4*)(lg + 64 + q * 8 + 4);
                    const int i0 = __float_as_int(tif[0]), i1 = __float_as_int(tif[1]), i2 = __float_as_int(tif[2]), i3 = __float_as_int(tif[3]);
                    const float e1 = __expf(tv[1] - tv[0]), e2 = __expf(tv[2] - tv[0]), e3 = __expf(tv[3] - tv[0]), inv = 1.0f / (1.0f + e1 + e2 + e3);
                    *(int4*)(tope + (size_t)tok * 4) = make_int4(i0, i1, i2, i3);
                    *(f32x4*)(topw + (size_t)tok * 4) = (f32x4){inv, e1 * inv, e2 * inv, e3 * inv};
                    const int sl = (F.wave * 32 + tl) * 4; le[sl] = i0; le[sl + 1] = i1; le[sl + 2] = i2; le[sl + 3] = i3; }
                LDS_WAIT(); asm volatile("" ::: "memory");
            }
        }
        __syncthreads();
#pragma unroll
        for (int rep = 0; rep < 2; ++rep) { const int sl = F.tid + rep * NTHR, me = le[sl]; int r = 0;
            for (int s2 = 0; s2 < sl; ++s2) r += (le[s2] == me) ? 1 : 0;
            rank[(size_t)unit * 1024 + sl] = r; }
        if (F.tid < 32) { int c = 0; for (int s2 = 0; s2 < 1024; ++s2) c += (le[s2] == F.tid) ? 1 : 0; hist[unit * 32 + F.tid] = c; }
        __syncthreads();
    }
}

__device__ __forceinline__ void p8_scatter(Frame& F) {
    F.fresh();
    const int* tope = (const int*)(F.ws + WS_TOPE); const float* topw = (const float*)(F.ws + WS_TOPW); const int* rank = (const int*)(F.ws + WS_RANK); const int* hist = (const int*)(F.ws + WS_HIST);
    int* rowtok = (int*)(F.ws + WS_ROWTOK); int* rowdst = (int*)(F.ws + WS_ROWDST); float* roww = (float*)(F.ws + WS_ROWW); int* tilee = (int*)(F.ws + WS_TILEE);
    LAS int* pre = (LAS int*)F.lds;
    LAS int* cnt = pre + 256 * 32;
    LAS int* pst = cnt + 64;
    constexpr int UPH = (NTOK / 256) / NHALF;
    static_assert((NTOK / 256) == 16 * (NTHR / 32) && UPH % 16 == 0, "two-level scan geometry");
    { LAS int* part = pst + 64;
      const int e = F.tid & 31, c = F.tid >> 5; int hv[16], tot = 0;
#pragma unroll
      for (int i = 0; i < 16; ++i) hv[i] = hist[(16 * c + i) * 32 + e];
#pragma unroll
      for (int i = 0; i < 16; ++i) { const int t_ = hv[i]; hv[i] = tot; tot += t_; }
      part[c * 32 + e] = tot;
      __syncthreads();
      if (F.tid < 32 * NHALF) { const int h = F.tid >> 5; int run = 0;
          for (int cc = 0; cc < UPH / 16; ++cc) { const int ix = (h * (UPH / 16) + cc) * 32 + e; const int t_ = part[ix]; part[ix] = run; run += t_; }
          cnt[F.tid] = run; }
      __syncthreads();
      const int off = part[c * 32 + e];
#pragma unroll
      for (int i = 0; i < 16; ++i) pre[(16 * c + i) * 32 + e] = off + hv[i]; }
    __syncthreads();
    if (F.tid < NHALF) { int run = 0; for (int e = 0; e < 32; ++e) { pst[F.tid * 32 + e] = run; run += (cnt[F.tid * 32 + e] + 255) & ~255; }
        if (F.vcu == 0) tilee[4096 + F.tid] = run / 256; }
    __syncthreads();
    if (F.vcu == 0) {
        for (int i = F.tid; i < NHALF * 32; i += NTHR) { const int h = i >> 5, e = i & 31; const int t0 = pst[i] / 256, t1 = t0 + ((cnt[i] + 255) >> 8);
            for (int t = t0; t < t1; ++t) tilee[h * 2048 + t] = e; }
    }
    for (int pe = F.vcu; pe < NHALF * 32; pe += F.G) {
        const int h = pe >> 5; const int r0 = pst[pe] + cnt[pe], r1 = pst[pe] + ((cnt[pe] + 255) & ~255);
        for (int r = r0 + F.tid; r < r1; r += NTHR) { rowtok[h * MAXROWS_H + r] = 0; rowdst[h * MAXROWS_H + r] = -1; roww[h * MAXROWS_H + r] = 0.f; }
    }
    for (int unit = F.vcu; unit < NTOK / 256; unit += F.G) {
        const int h = unit / UPH;
        for (int s = F.tid; s < 1024; s += NTHR) {
            const int slot = unit * 1024 + s, tok = slot >> 2, e = tope[slot];
            const int row = pst[h * 32 + e] + pre[unit * 32 + e] + rank[slot];
            rowtok[h * MAXROWS_H + row] = tok; rowdst[h * MAXROWS_H + row] = slot - h * (HTOK * 4); roww[h * MAXROWS_H + row] = topw[slot];
        }
    }
    __syncthreads();
}

__device__ __forceinline__ void p_final(Frame& F, const Args& a, int h, float* outp) {
    F.fresh();
    const float* ln2g = a.in[18]; const float* ln2b = a.in[19]; const float* mod = (const float*)(F.ws + WS_MOD); const bf16_t* yb = (const bf16_t*)(F.ws + WS_YB);
    const int gw = F.vcu * NWAVES + F.wave, NGW = F.G * NWAVES;
    f32x4 g2r[4], b2r[4], g1r[4], b1r[4], gmr[4];
#pragma unroll
    for (int j = 0; j < 4; ++j) { g2r[j] = ((const f32x4*)ln2g + F.lane)[64 * j]; b2r[j] = ((const f32x4*)ln2b + F.lane)[64 * j]; g1r[j] = ((const f32x4*)a.in[10] + F.lane)[64 * j]; b1r[j] = ((const f32x4*)a.in[11] + F.lane)[64 * j]; }
    const int per = (HTOK + NGW - 1) / NGW; int bcur = -1;
    for (int tl = gw * per; tl < HTOK && tl < (gw + 1) * per; ++tl) {
        const int tok = h * HTOK + tl, b = tok / SEQ;
        if (b != bcur) { bcur = b;
#pragma unroll
            for (int j = 0; j < 4; ++j) gmr[j] = ((const f32x4*)(mod + b * 6144 + 5 * 1024) + F.lane)[64 * j]; }
        const u32x2* y0 = (const u32x2*)(yb + (size_t)tl * 4 * 1024) + F.lane; const unsigned* y8 = (const unsigned*)((const unsigned char*)yb + (size_t)tl * 4 * 1024) + F.lane;
        const f32x2 ms1 = *(const f32x2*)((const float*)(F.ws + WS_ST1) + (size_t)tok * 2); const float m1 = ms1[0], r1 = ms1[1];
        f32x4 v[4], pr[4]; float s = 0.f;
        { const u32x2* p2 = (const u32x2*)(a.out + (size_t)tok * D) + F.lane;
#pragma unroll
          for (int j = 0; j < 4; ++j) { const u32x2 w = p2[64 * j]; pr[j] = (f32x4){bf_lo(w.x), bf_hi(w.x), bf_lo(w.y), bf_hi(w.y)}; } }
#pragma unroll
        for (int j = 0; j < 4; ++j) {
            f32x4 hm = {0.f, 0.f, 0.f, 0.f};
#pragma unroll
            for (int k = 0; k < 4; ++k) {
                if (YB_F8) { typedef float f32x2_ __attribute__((ext_vector_type(2))); const unsigned w = y8[k * 256 + 64 * j];
                    const f32x2_ lo = __builtin_amdgcn_cvt_pk_f32_fp8((int)w, false), hi2 = __builtin_amdgcn_cvt_pk_f32_fp8((int)w, true); hm += (f32x4){lo[0], lo[1], hi2[0], hi2[1]}; }
                else { const u32x2 w = y0[k * 256 + 64 * j]; hm += (f32x4){bf_lo(w.x), bf_hi(w.x), bf_lo(w.y), bf_hi(w.y)}; } }
            if (YB_F8) hm = hm * 0.125f;
            const f32x4 x1 = (pr[j] - m1) * r1 * g1r[j] + b1r[j];
            v[j] = x1 * DN_ALPHA + gmr[j] * hm; s += (v[j][0] + v[j][1]) + (v[j][2] + v[j][3]); }
        const float mean = wave_sum(s) * (1.f / D); float s2 = 0.f;
#pragma unroll
        for (int j = 0; j < 4; ++j) { v[j] = v[j] - mean; s2 += (v[j][0] * v[j][0] + v[j][1] * v[j][1]) + (v[j][2] * v[j][2] + v[j][3] * v[j][3]); }
        const float rstd = 1.f / sqrtf(wave_sum(s2) * (1.f / D) + 1e-5f);
        f32x4* orow = (f32x4*)(outp + (size_t)tok * D) + F.lane;
#pragma unroll
        for (int j = 0; j < 4; ++j) orow[64 * j] = v[j] * rstd * g2r[j] + b2r[j];
    }
}


#define GBAR(n) xcd_barrier(bar)
#define PH(k) 1
__global__ void __launch_bounds__(NTHR, 2) hyb_fwd(Args args) {
    extern __shared__ __attribute__((aligned(16))) unsigned char lds[];
    Frame F;
    F.lds = (LAS unsigned char*)lds; F.fresh();
    F.G = gridDim.x; { const int bx = blockIdx.x; F.vcu = (F.G % 8 == 0) ? (bx % 8) * (F.G / 8) + bx / 8 : bx; }
    F.ws = args.ws;
    volatile LAS unsigned* MISC = (volatile LAS unsigned*)(F.lds + MISC_OFF);
    for (int u = F.tid; u < 64; u += NTHR) ((LAS unsigned*)(F.lds + MISC_OFF))[u] = 0u;
    __syncthreads();
    XcdBarrier bar = xcd_barrier_post((unsigned*)(F.ws + WS_CTL) + CW_BAR, MISC + 8);
    unsigned char* ws = F.ws;
    const float* x = args.in[0];
    const float* mod = (const float*)(ws + WS_MOD);

    if (PH(0)) p0_prologue(F, args);
    GBAR(1);
    if (PH(1)) p1_adaln(F, x);
    GBAR(2);
    {
        pg8::Gemm g{(const bf16_t*)(ws + WS_U), (const bf16_t*)(ws + WS_WIN), nullptr, 1024};
        pg8::DenseOrder S{NTOK / 256, NIN / 256, F.G, (int)blockIdx.x, INPROJ_F8 ? 1024 : 2048};
        pg8::EpiInProj E{(bf16_t*)(ws + WS_H), (bf16_t*)(ws + WS_Q), (bf16_t*)(ws + WS_K), (bf16_t*)(ws + WS_V), (bf16_t*)(ws + WS_G), INPROJ_F8 ? 0.03125f : 1.0f};
        pg8::gemm_phase<pg8::EpiInProj, pg8::DenseOrder, false, ALIGN_P2, INPROJ_F8 != 0>(F.lds, g, S, E);
    }
    GBAR(3);
    if (PH(3)) p3_qknorm_rope(F, args.in[5], args.in[6]);
    if (ATT_PV8) p3_vt8(F);
    if (PH(4)) {
        bf16_t* Hb = (bf16_t*)(ws + WS_H); const bf16_t* M1 = (const bf16_t*)(ws + WS_M1);
        F.fresh();
#define D1_BBASE(u_) (Hb + ((size_t)(((u_) >> 7) * SEQ + (F.tid >> 5) * 128 + ((u_) & 127))) * 1024 + ((F.tid >> 4) & 1) * 512 + (F.tid & 15) * 8)
        u32x4 st1_[4];
        if (F.vcu < BATCH * 128) {
#pragma unroll
            for (int i = 0; i < 4; ++i) st1_[i] = *(const u32x4*)(D1_BBASE(F.vcu) + i * (size_t)16 * 128 * 1024); }
        for (int u = F.vcu; u < BATCH * 128; u += F.G) {
            const int b = u >> 7, s2 = u & 127;
            const bf16_t* bbase = D1_BBASE(u); const bf16_t* bnext = (u + F.G < BATCH * 128) ? D1_BBASE(u + F.G) : nullptr;
            const int mi_ = F.wave & 3, m0_ = 32 * mi_ + 4 * (F.lane >> 5);
            bf16_t* obase = (bf16_t*)(ws + WS_T) + ((size_t)(b * SEQ + (m0_ & 63) * 128 + s2)) * 1024 + (m0_ >> 6) * 512 + (F.lane & 31);
            dft::dft_unit<8>(F.lds, M1, bbase, (size_t)16 * 128 * 1024, obase, (size_t)128 * 1024, st1_, bnext);
        }
    }
    GBAR(4);
    if (PH(5)) {
        bf16_t* Q = (bf16_t*)(ws + WS_Q); const bf16_t* Kb = (const bf16_t*)(ws + WS_K); const bf16_t* Vb = (const bf16_t*)(ws + WS_V);
        const float Mnat = *(const volatile float*)(ws + WS_CTL + 61 * 1024);
        const bool fixed_ok = __builtin_amdgcn_readfirstlane((int)(Mnat < 43.0f)) != 0;
        const float* rR = (const float*)(ws + WS_ROPE_R); const float* rC = (const float*)(ws + WS_ROPE_C);
#define ATT_UNITS(FX) for (int u = F.vcu; u < BATCH * 8 * 32; u += F.G) { \
            const int qb = u & 31, hq = (u >> 5) & 7, b = u >> 8, kvh = hq >> 2; \
            bf16_t* Qp = Q + ((size_t)(b * SEQ + qb * 256)) * 1024 + hq * 128; \
            att::attn_dense_body<FX>(Qp, Kb + (size_t)b * SEQ * 256 + kvh * 128, Vb + (size_t)b * SEQ * 256 + kvh * 128, Qp, SEQ, (char*)lds, args.in[5], rR, rC, qb * 256); \
            if (MIX_F8) att::o_bf16_to_fp8(Qp, ws + WS_U2 + ((size_t)(b * SEQ + qb * 256)) * 1024 + hq * 128); }
        if (fixed_ok && ATT_DMA && ATT_QK8 && ATT_PV8 && ATT_PHASED && (SEQ / 64) % 2 == 0) {
            const int tid_ = tid_fresh(); const bool lag_ = __builtin_amdgcn_readfirstlane(tid_ >> 8) != 0;
#define ATT_PUNITS(LG) for (int u = F.vcu; u < BATCH * 8 * 32; u += F.G) { \
                const int qb = u & 31, hq = (u >> 5) & 7, b = u >> 8, kvh = hq >> 2; \
                bf16_t* Qp = Q + ((size_t)(b * SEQ + qb * 256)) * 1024 + hq * 128; \
                att::attn_f8p_body<LG>(Qp, ws + WS_KF8 + (size_t)b * SEQ * 256 + kvh * 128, ws + WS_VT8 + (size_t)((b * 2 + kvh) * 128) * 8192, Qp, SEQ, (char*)lds, args.in[5], rR, rC, qb * 256); \
                if (MIX_F8) att::o_bf16_to_fp8(Qp, ws + WS_U2 + ((size_t)(b * SEQ + qb * 256)) * 1024 + hq * 128); }
            if (lag_) { ATT_PUNITS(true) } else { ATT_PUNITS(false) }
#undef ATT_PUNITS
        } else if (fixed_ok && ATT_DMA && ATT_QK8 && ATT_PV8 && ((SEQ / 64) % 4 == 0)) {
            for (int u = F.vcu; u < BATCH * 8 * 32; u += F.G) {
                const int qb = u & 31, hq = (u >> 5) & 7, b = u >> 8, kvh = hq >> 2;
                bf16_t* Qp = Q + ((size_t)(b * SEQ + qb * 256)) * 1024 + hq * 128;
                bf16_t* Op = MIX_F8 ? (bf16_t*)(ws + WS_U2 + ((size_t)(b * SEQ + qb * 256)) * 1024 + hq * 128) : Qp;
                att::attn_f8_body(Qp, ws + (ATT_QK6 ? WS_K6 : WS_KF8) + (size_t)b * SEQ * 256 + kvh * 128, ws + WS_VT8 + (size_t)((b * 2 + kvh) * 128) * 8192, Op, SEQ, (char*)lds, args.in[5], rR, rC, qb * 256); }
        } else if (fixed_ok && ATT_DMA && ((SEQ / 64 - 1) % 6 == 1)) {
            for (int u = F.vcu; u < BATCH * 8 * 32; u += F.G) {
                const int qb = u & 31, hq = (u >> 5) & 7, b = u >> 8, kvh = hq >> 2;
                bf16_t* Qp = Q + ((size_t)(b * SEQ + qb * 256)) * 1024 + hq * 128;
                bf16_t* Op = Qp;
                att::attn_dma_body<ATT_QK8 != 0>(Qp, Kb + (size_t)b * SEQ * 256 + kvh * 128, ws + WS_KF8 + (size_t)b * SEQ * 256 + kvh * 128, Vb + (size_t)b * SEQ * 256 + kvh * 128, Op, SEQ, (char*)lds, args.in[5], rR, rC, qb * 256);
                if (MIX_F8 && Op == Qp) att::o_bf16_to_fp8(Qp, ws + WS_U2 + ((size_t)(b * SEQ + qb * 256)) * 1024 + hq * 128); }
        } else if (fixed_ok) { ATT_UNITS(true) } else { ATT_UNITS(false) }
#undef ATT_UNITS
    }
    if (PH(6)) {
        const bf16_t* Tb = (const bf16_t*)(ws + WS_H); bf16_t* Y = (bf16_t*)(ws + WS_U); const bf16_t* Et = (const bf16_t*)(ws + WS_ETAB);
        F.fresh();
#define D3_BBASE(u_) (Tb + ((size_t)(((u_) >> 6) * SEQ + ((u_) & 63) * 128)) * 1024 + (size_t)(F.tid >> 4) * 512 + (F.tid & 15) * 8)
        u32x4 st3_[8];
        if (F.vcu < BATCH * 64) {
#pragma unroll
            for (int i = 0; i < 8; ++i) st3_[i] = *(const u32x4*)(D3_BBASE(F.vcu) + i * (size_t)32 * 512); }
        for (int u = F.vcu; u < BATCH * 64; u += F.G) {
            const int b = u >> 6, k1 = u & 63;
            const bf16_t* bbase = D3_BBASE(u); const bf16_t* bnext = (u + F.G < BATCH * 64) ? D3_BBASE(u + F.G) : nullptr;
            const int m0_ = 32 * (F.wave & 3) + 4 * (F.lane >> 5);
            if (MIX_F8) { unsigned char* ob8 = (unsigned char*)Y + ((size_t)(b * SEQ + k1 + 64 * m0_)) * 512 + (F.lane & 31);
                dft::dft_unit<16, true>(F.lds, Et + (size_t)k1 * 128 * 256, bbase, (size_t)32 * 512, (bf16_t*)ob8, (size_t)64 * 512, st3_, bnext); continue; }
            bf16_t* obase = Y + ((size_t)(b * SEQ + k1 + 64 * m0_)) * 512 + (F.lane & 31);
            dft::dft_unit<16>(F.lds, Et + (size_t)k1 * 128 * 256, bbase, (size_t)32 * 512, obase, (size_t)64 * 512, st3_, bnext);
        }
    }
    GBAR(5);
    if (P5_FUSED) {
        pg8::gemm_p5_fused(F.lds, (const bf16_t*)(ws + WS_U), (const bf16_t*)(ws + WS_WF), (const bf16_t*)(ws + (MIX_F8 ? WS_U2 : WS_Q)), (const bf16_t*)(ws + WS_WAO), (const bf16_t*)(ws + WS_G), (bf16_t*)(ws + WS_H), F.G, (int)blockIdx.x);
    } else
    {
    if (PH(7)) {
        pg8::Gemm g{(const bf16_t*)(ws + WS_U), (const bf16_t*)(ws + WS_WF), nullptr, 512};
        pg8::DenseOrder S{NTOK / 256, 4, F.G, (int)blockIdx.x, 1024};
        pg8::EpiGateF E{(const bf16_t*)(ws + WS_G), (bf16_t*)args.out};
        pg8::gemm_phase<pg8::EpiGateF, pg8::DenseOrder, false, ALIGN_MIX>(F.lds, g, S, E);
    }
    __syncthreads();
    if (PH(8)) {
        pg8::Gemm g{(const bf16_t*)(ws + WS_Q), (const bf16_t*)(ws + WS_WAO), nullptr, 1024};
        pg8::DenseOrder S{NTOK / 256, 4, F.G, (int)blockIdx.x, 2048};
        pg8::EpiGateA E{(const bf16_t*)(ws + WS_G), (const bf16_t*)args.out, (bf16_t*)(ws + WS_H)};
        pg8::gemm_phase<pg8::EpiGateA, pg8::DenseOrder, false, ALIGN_MIX>(F.lds, g, S, E);
    }
    __syncthreads();
    }
    GBAR(6);
    {
        pg8::Gemm g{(const bf16_t*)(ws + WS_H), (const bf16_t*)(ws + WS_WOUT), nullptr, 1024};
        pg8::DenseOrder S{NTOK / 256, 4, F.G, (int)blockIdx.x, MIX_F8 ? 1024 : 2048};
        pg8::EpiOut E{x, mod, args.out, MIX_F8 ? 1.0f / 32.0f : 1.0f};
        pg8::gemm_phase<pg8::EpiOut, pg8::DenseOrder, false, ALIGN_MIX, MIX_F8 != 0>(F.lds, g, S, E);
    }
    GBAR(7);
    if (PH(10)) p7_ln_router(F, args);
    GBAR(8);
    if (PH(11)) p8_scatter(F);
    GBAR(9);
    const int* tilee = (const int*)(ws + WS_TILEE);
    for (int h = 0; h < NHALF; ++h) {
        const int ntiles = __builtin_amdgcn_readfirstlane(tilee[4096 + h]);
        if (h > 0 && PH(14)) p_final(F, args, h - 1, args.out);
        {
            pg8::Gemm g{(const bf16_t*)(ws + WS_U2), (const bf16_t*)(ws + WS_WGU), (const int*)(ws + WS_ROWTOK) + h * MAXROWS_H, 1024};
            pg8::MoeOrder S{ntiles, 8, F.G, (int)blockIdx.x, 1024, tilee + h * 2048, (size_t)2048 * 1024};
            pg8::EpiSwiglu E{args.in[15], ws + WS_ACT};
            pg8::gemm_phase<pg8::EpiSwiglu, pg8::MoeOrder, true, ALIGN_UP, true>(F.lds, g, S, E);
        }
        GBAR(10);
        {
            pg8::Gemm g{(const bf16_t*)(ws + WS_ACT), (const bf16_t*)(ws + WS_WD), nullptr, 1024};
            pg8::MoeOrder S{ntiles, 4, F.G, (int)blockIdx.x, 1024, tilee + h * 2048, (size_t)1024 * 1024};
            pg8::EpiDown E{args.in[17], (const int*)(ws + WS_ROWDST) + h * MAXROWS_H, (const float*)(ws + WS_ROWW) + h * MAXROWS_H, (bf16_t*)(ws + WS_YB)};
            pg8::gemm_phase<pg8::EpiDown, pg8::MoeOrder, false, ALIGN_DN, true>(F.lds, g, S, E);
        }
        GBAR(11);
    }
    if (PH(14)) p_final(F, args, NHALF - 1, args.out);
}

extern "C" void kernel_launch(void* const* d_in, const int* in_sizes, int n_in, void* d_out, int out_size, void* d_ws, size_t ws_size, hipStream_t stream) {
    static int grid = 0;
    if (grid == 0) {
        if (n_in != 20 || out_size != NTOK * D || ws_size < WS_END) { fprintf(stderr, "kernel_launch: unexpected shapes (n_in %d out %d ws %zu)\n", n_in, out_size, ws_size); grid = -1; return; }
        int dev = 0, cus = 0;
        if (hipGetDevice(&dev) != hipSuccess || hipDeviceGetAttribute(&cus, hipDeviceAttributeMultiprocessorCount, dev) != hipSuccess) { grid = -1; return; }
        if (hipFuncSetAttribute((const void*)hyb_fwd, hipFuncAttributeMaxDynamicSharedMemorySize, LDS_BYTES) != hipSuccess) { fprintf(stderr, "kernel_launch: hipFuncSetAttribute failed\n"); grid = -1; return; }
        int per_cu = 0;
        if (hipOccupancyMaxActiveBlocksPerMultiprocessor(&per_cu, (const void*)hyb_fwd, NTHR, LDS_BYTES) != hipSuccess || per_cu < 1) { fprintf(stderr, "kernel_launch: occupancy query says %d\n", per_cu); }
        (void)hipGetLastError();
        grid = cus;
    }
    if (grid < 0) return;
    if (hipMemsetAsync((char*)d_ws + WS_CTL, 0, CTL_ZERO_BYTES, stream) != hipSuccess) return;
    Args a{};
    for (int i = 0; i < 20; ++i) a.in[i] = (const float*)d_in[i];
    a.out = (float*)d_out; a.ws = (unsigned char*)d_ws;
    hipLaunchKernelGGL(hyb_fwd, dim3(grid), dim3(NTHR), LDS_BYTES, stream, a);
}
```
